# Optimizing an MI355X kernel written in HIP

```python
import jax, jax.numpy as jnp
from jax import lax
import numpy as np

D_MODEL = 1024
BATCH = 16
SEQ = 2048
DEPTH = 4

CHUNK = 64
N_MIXERS = 3
N_RGLRU_LAYERS = (DEPTH + 2) // 3
N_RWKV_LAYERS = (DEPTH + 1) // 3
N_ATTN_LAYERS = DEPTH // 3

DEEPNORM_ALPHA = (2 * DEPTH) ** 0.25
DEEPNORM_BETA = (8 * DEPTH) ** -0.25
LN_EPS = 1e-5

D_RNN = 1344
LRU_BLOCKS = 16
LRU_BLOCK_SIZE = D_RNN // LRU_BLOCKS
CONV_WIDTH = 4
RG_LRU_C = 8.0

RW_HEAD_SIZE = 64
RW_HEADS = D_MODEL // RW_HEAD_SIZE
RW_DECAY_LORA = 64
RW_AAA_LORA = 64
RW_GATE_LORA = 128
RW_GN_EPS = 64e-5

ATT_HEADS = 16
ATT_HEAD_DIM = D_MODEL // ATT_HEADS
BAND_CHUNKS = 9
BAND = BAND_CHUNKS * CHUNK
MAX_REL = 2 * CHUNK
NEG_INF = -1e30

MEM_TOKENS = 256
MEM_HEADS = 4
MEM_HEAD_DIM = D_MODEL // MEM_HEADS

D_FF = 4 * D_MODEL

kernel_name = "hybrid_rglru_rwkv7_chunkattn_deepnorm"


def _layer_norm(x, g, b):
    xf = x.astype(jnp.float32)
    mu = jnp.mean(xf, axis=-1, keepdims=True)
    var = jnp.mean(jnp.square(xf - mu), axis=-1, keepdims=True)
    return ((xf - mu) * lax.rsqrt(var + LN_EPS) * g + b).astype(x.dtype)


def _causal_depthwise_conv(x, w, b):
    k, c = w.shape
    y = lax.conv_general_dilated(x, w[:, None, :], window_strides=(1,), padding=[(k - 1, 0)],
                                 dimension_numbers=('NWC', 'WIO', 'NWC'), feature_group_count=c)
    return y + b


def _linear_recurrence_combine(left, right):
    a_l, b_l = left
    a_r, b_r = right
    return a_l * a_r, a_r * b_l + b_r


def rglru_block(x, w_in, conv_w, conv_b, gate_w, gate_b, lam, w_out):
    bsz, seq, _ = x.shape
    u = x @ w_in
    gate_branch = jax.nn.gelu(u[..., :D_RNN])
    xr = _causal_depthwise_conv(u[..., D_RNN:], conv_w, conv_b)
    xb = xr.reshape(bsz, seq, LRU_BLOCKS, LRU_BLOCK_SIZE)
    gates = jnp.einsum('bsnc,gncd->bsgnd', xb, gate_w).reshape(bsz, seq, 2, D_RNN) + gate_b
    gates = jax.nn.sigmoid(gates.astype(jnp.float32))
    r_gate, i_gate = gates[:, :, 0], gates[:, :, 1]
    log_a = -RG_LRU_C * r_gate * jax.nn.softplus(-lam.astype(jnp.float32))
    a = jnp.exp(log_a)
    bterm = jnp.sqrt(-jnp.expm1(2.0 * log_a)) * (i_gate * xr.astype(jnp.float32))
    _, h = lax.associative_scan(_linear_recurrence_combine, (a, bterm), axis=1)
    return (h.astype(x.dtype) * gate_branch) @ w_out


def rwkv7_time_mix(x, mu, w_r, w_k, w_v, w0, w1, w2, a0, a1, a2, g1, g2, k_k, k_a, r_k,
                   lnx_g, lnx_b, w_o):
    bsz, seq, d = x.shape
    f32 = jnp.float32
    xx = jnp.pad(x, ((0, 0), (1, 0), (0, 0)))[:, :-1] - x
    xr, xw, xk, xv, xa, xg = [x + xx * mu[c] for c in range(6)]
    r = (xr @ w_r).astype(f32)
    k = (xk @ w_k).astype(f32)
    v = (xv @ w_v).astype(f32)
    w_log = -jax.nn.softplus(-(w0 + jnp.tanh(xw @ w1) @ w2).astype(f32)) - 0.5
    decay = jnp.exp(-jnp.exp(w_log))
    a = jax.nn.sigmoid((a0 + (xa @ a1) @ a2).astype(f32))
    g = (jax.nn.sigmoid(xg @ g1) @ g2).astype(f32)
    kk = (k * k_k).reshape(bsz, seq, RW_HEADS, RW_HEAD_SIZE)
    kk = kk / jnp.maximum(jnp.linalg.norm(kk, axis=-1, keepdims=True), 1e-12)
    k = k * (1.0 + (a - 1.0) * k_a)

    heads = lambda t: jnp.moveaxis(t.reshape(bsz, seq, RW_HEADS, RW_HEAD_SIZE), 1, 0)
    a_h = a.reshape(bsz, seq, RW_HEADS, RW_HEAD_SIZE)
    seq_inputs = (heads(r), heads(decay), heads(k), heads(v),
                  jnp.moveaxis(-kk, 1, 0), jnp.moveaxis(kk * a_h, 1, 0))

    def step(state, inp):
        r_t, w_t, k_t, v_t, aa_t, bb_t = inp
        sa = jnp.einsum('bhij,bhj->bhi', state, aa_t)
        state = (state * w_t[:, :, None, :] + sa[..., None] * bb_t[:, :, None, :]
                 + v_t[..., None] * k_t[:, :, None, :])
        return state, jnp.einsum('bhij,bhj->bhi', state, r_t)

    state0 = jnp.zeros((bsz, RW_HEADS, RW_HEAD_SIZE, RW_HEAD_SIZE), f32)
    _, y = lax.scan(step, state0, seq_inputs)
    y = jnp.moveaxis(y, 0, 1)
    mu_y = jnp.mean(y, axis=-1, keepdims=True)
    var_y = jnp.mean(jnp.square(y - mu_y), axis=-1, keepdims=True)
    y = ((y - mu_y) * lax.rsqrt(var_y + RW_GN_EPS)).reshape(bsz, seq, d) * lnx_g + lnx_b
    rh = r.reshape(bsz, seq, RW_HEADS, RW_HEAD_SIZE)
    kh = k.reshape(bsz, seq, RW_HEADS, RW_HEAD_SIZE)
    vh = v.reshape(bsz, seq, RW_HEADS, RW_HEAD_SIZE)
    bonus = (jnp.sum(rh * kh * r_k, axis=-1, keepdims=True) * vh).reshape(bsz, seq, d)
    return ((y + bonus) * g).astype(x.dtype) @ w_o


def chunk_relpos_attention(x, w_qkv, rel_bias, w_o):
    bsz, seq, d = x.shape
    n_chunks = seq // CHUNK
    left = (BAND_CHUNKS - 1) * CHUNK
    qkv = (x @ w_qkv).reshape(bsz, seq, 3, ATT_HEADS, ATT_HEAD_DIM)
    q = qkv[:, :, 0] * (ATT_HEAD_DIM ** -0.5)
    kp = jnp.pad(qkv[:, :, 1], ((0, 0), (left, 0), (0, 0), (0, 0)))
    vp = jnp.pad(qkv[:, :, 2], ((0, 0), (left, 0), (0, 0), (0, 0)))
    rel = (left + jnp.arange(CHUNK))[:, None] - jnp.arange(BAND)[None, :]
    bias = rel_bias[:, jnp.clip(rel, -MAX_REL, MAX_REL) + MAX_REL].astype(jnp.float32)

    def one_chunk(c):
        start = c * CHUNK
        qc = lax.dynamic_slice_in_dim(q, start, CHUNK, axis=1)
        kc = lax.dynamic_slice_in_dim(kp, start, BAND, axis=1)
        vc = lax.dynamic_slice_in_dim(vp, start, BAND, axis=1)
        s = jnp.einsum('bqhd,bkhd->bhqk', qc, kc).astype(jnp.float32) + bias
        valid = (start - left + jnp.arange(BAND)) >= 0
        s = jnp.where(valid[None, None, None, :], s, NEG_INF)
        p = jax.nn.softmax(s, axis=-1).astype(vc.dtype)
        return jnp.einsum('bhqk,bkhd->bqhd', p, vc)

    out = lax.map(one_chunk, jnp.arange(n_chunks))
    out = jnp.transpose(out, (1, 0, 2, 3, 4)).reshape(bsz, seq, d)
    return out @ w_o


def memory_cross_attention(x, mem, w_q, w_kv, w_o):
    bsz, seq, d = x.shape
    q = (x @ w_q).reshape(bsz, seq, MEM_HEADS, MEM_HEAD_DIM)
    kv = (mem @ w_kv).reshape(bsz, mem.shape[1], 2, MEM_HEADS, MEM_HEAD_DIM)
    s = jnp.einsum('bqhd,bkhd->bhqk', q, kv[:, :, 0]).astype(jnp.float32) * (MEM_HEAD_DIM ** -0.5)
    p = jax.nn.softmax(s, axis=-1).astype(x.dtype)
    o = jnp.einsum('bhqk,bkhd->bqhd', p, kv[:, :, 1]).reshape(bsz, seq, d)
    return o @ w_o


def squared_relu_mlp(x, w1, w2):
    return jnp.square(jax.nn.relu(x @ w1)) @ w2


def _normal(key, shape, scale):
    return scale * jax.random.normal(key, shape, jnp.float32)


def setup_inputs(seed: int = 0) -> dict:
    key = jax.random.key(seed)
    ks = iter(jax.random.split(key, 40))
    d = D_MODEL
    n_a, n_b, n_c = N_RGLRU_LAYERS, N_RWKV_LAYERS, N_ATTN_LAYERS
    beta = DEEPNORM_BETA
    lam_u = jax.random.uniform(next(ks), (n_a, D_RNN), jnp.float32, minval=0.9, maxval=0.999)
    lam_s = lam_u ** (1.0 / RG_LRU_C)
    return {
        "x": _normal(next(ks), (BATCH, SEQ, d), 1.0),
        "mem": _normal(next(ks), (BATCH, MEM_TOKENS, d), 1.0),
        "ln_g": 1.0 + _normal(next(ks), (DEPTH, 3, d), 0.02),
        "ln_b": _normal(next(ks), (DEPTH, 3, d), 0.02),
        "lru_w_in": _normal(next(ks), (n_a, d, 2 * D_RNN), d ** -0.5),
        "lru_conv_w": _normal(next(ks), (n_a, CONV_WIDTH, D_RNN), CONV_WIDTH ** -0.5),
        "lru_conv_b": _normal(next(ks), (n_a, D_RNN), 0.02),
        "lru_gate_w": _normal(next(ks), (n_a, 2, LRU_BLOCKS, LRU_BLOCK_SIZE, LRU_BLOCK_SIZE), LRU_BLOCK_SIZE ** -0.5),
        "lru_gate_b": _normal(next(ks), (n_a, 2, D_RNN), 0.02),
        "lru_lambda": jnp.log(lam_s) - jnp.log1p(-lam_s),
        "lru_w_out": _normal(next(ks), (n_a, D_RNN, d), beta * D_RNN ** -0.5),
        "rw_mu": jax.random.uniform(next(ks), (n_b, 6, d), jnp.float32),
        "rw_w_r": _normal(next(ks), (n_b, d, d), d ** -0.5),
        "rw_w_k": _normal(next(ks), (n_b, d, d), d ** -0.5),
        "rw_w_v": _normal(next(ks), (n_b, d, d), d ** -0.5),
        "rw_w0": jax.random.uniform(next(ks), (n_b, d), jnp.float32, minval=-6.0, maxval=-1.0),
        "rw_w1": _normal(next(ks), (n_b, d, RW_DECAY_LORA), d ** -0.5),
        "rw_w2": _normal(next(ks), (n_b, RW_DECAY_LORA, d), 0.5 * RW_DECAY_LORA ** -0.5),
        "rw_a0": _normal(next(ks), (n_b, d), 0.1),
        "rw_a1": _normal(next(ks), (n_b, d, RW_AAA_LORA), d ** -0.5),
        "rw_a2": _normal(next(ks), (n_b, RW_AAA_LORA, d), RW_AAA_LORA ** -0.5),
        "rw_g1": _normal(next(ks), (n_b, d, RW_GATE_LORA), d ** -0.5),
        "rw_g2": _normal(next(ks), (n_b, RW_GATE_LORA, d), RW_GATE_LORA ** -0.5),
        "rw_k_k": 0.85 + _normal(next(ks), (n_b, d), 0.02),
        "rw_k_a": 1.0 + _normal(next(ks), (n_b, d), 0.02),
        "rw_r_k": _normal(next(ks), (n_b, RW_HEADS, RW_HEAD_SIZE), 0.1),
        "rw_lnx_g": 1.0 + _normal(next(ks), (n_b, d), 0.02),
        "rw_lnx_b": _normal(next(ks), (n_b, d), 0.02),
        "rw_w_o": _normal(next(ks), (n_b, d, d), beta * d ** -0.5),
        "ca_w_qkv": _normal(next(ks), (n_c, d, 3 * d), d ** -0.5),
        "ca_rel_bias": _normal(next(ks), (n_c, ATT_HEADS, 2 * MAX_REL + 1), 0.2),
        "ca_w_o": _normal(next(ks), (n_c, d, d), beta * d ** -0.5),
        "mx_w_q": _normal(next(ks), (DEPTH, d, d), d ** -0.5),
        "mx_w_kv": _normal(next(ks), (DEPTH, d, 2 * d), d ** -0.5),
        "mx_w_o": _normal(next(ks), (DEPTH, d, d), beta * d ** -0.5),
        "mlp_w1": _normal(next(ks), (DEPTH, d, D_FF), d ** -0.5),
        "mlp_w2": _normal(next(ks), (DEPTH, D_FF, d), beta * D_FF ** -0.5),
    }


def reference(x, mem, ln_g, ln_b,
              lru_w_in, lru_conv_w, lru_conv_b, lru_gate_w, lru_gate_b, lru_lambda, lru_w_out,
              rw_mu, rw_w_r, rw_w_k, rw_w_v, rw_w0, rw_w1, rw_w2, rw_a0, rw_a1, rw_a2, rw_g1, rw_g2,
              rw_k_k, rw_k_a, rw_r_k, rw_lnx_g, rw_lnx_b, rw_w_o,
              ca_w_qkv, ca_rel_bias, ca_w_o,
              mx_w_q, mx_w_kv, mx_w_o, mlp_w1, mlp_w2):
    h = x
    for i in range(DEPTH):
        kind, j = i % N_MIXERS, i // N_MIXERS
        if kind == 0:
            y = rglru_block(h, lru_w_in[j], lru_conv_w[j], lru_conv_b[j], lru_gate_w[j],
                            lru_gate_b[j], lru_lambda[j], lru_w_out[j])
        elif kind == 1:
            y = rwkv7_time_mix(h, rw_mu[j], rw_w_r[j], rw_w_k[j], rw_w_v[j], rw_w0[j], rw_w1[j],
                               rw_w2[j], rw_a0[j], rw_a1[j], rw_a2[j], rw_g1[j], rw_g2[j],
                               rw_k_k[j], rw_k_a[j], rw_r_k[j], rw_lnx_g[j], rw_lnx_b[j], rw_w_o[j])
        else:
            y = chunk_relpos_attention(h, ca_w_qkv[j], ca_rel_bias[j], ca_w_o[j])
        h = _layer_norm(DEEPNORM_ALPHA * h + y, ln_g[i, 0], ln_b[i, 0])
        y = memory_cross_attention(h, mem, mx_w_q[i], mx_w_kv[i], mx_w_o[i])
        h = _layer_norm(DEEPNORM_ALPHA * h + y, ln_g[i, 1], ln_b[i, 1])
        y = squared_relu_mlp(h, mlp_w1[i], mlp_w2[i])
        h = _layer_norm(DEEPNORM_ALPHA * h + y, ln_g[i, 2], ln_b[i, 2])
    return h
```

```cpp
#include <hip/hip_runtime.h>
#include <hip/hip_cooperative_groups.h>
#include <cstdio>
#include <cstdint>
namespace cg = cooperative_groups;
__device__ __forceinline__ int tidx() { int t = (int)threadIdx.x; asm volatile("" : "+v"(t)); return t; }
__device__ __forceinline__ int bidx() { int t = (int)blockIdx.x; asm volatile("" : "+s"(t)); return t; }
__device__ __forceinline__ int gdim() { int t = (int)gridDim.x; asm volatile("" : "+s"(t)); return t; }
#define MK_COOP 1
namespace pg8 {
#define PG8_LAS __attribute__((address_space(3)))
typedef unsigned short bf16_t;
typedef short bf16x8 __attribute__((ext_vector_type(8)));
typedef float f32x4 __attribute__((ext_vector_type(4)));
typedef unsigned u32x4 __attribute__((ext_vector_type(4)));
constexpr int BM = 256, BK = 64, HALF = 128, HTB = HALF * BK * 2  , STAGE_BYTES = 8 * HTB, NXCD = 8, WGM = 8;

__host__ __device__ __forceinline__ int lds_byte(int r, int c) { const int st = (r >> 4) * 2 + (c >> 5), rr = r & 15, cc = c & 31, ob = rr * 64 + cc * 2; return st * 1024 + (ob ^ (((ob >> 9) & 1) << 5)); }
__host__ __device__ __forceinline__ void stage_rc(int b, int& R, int& C) { const int st = b / 1024, sb = b % 1024, swz = sb ^ (((sb >> 9) & 1) << 5); R = (st >> 1) * 16 + swz / 64; C = (st & 1) * 32 + (swz % 64) / 2; }
__host__ __device__ __forceinline__ int perm32(int rho) { const int n = rho >> 4, i = rho & 15; return 8 * (i >> 2) + 4 * n + (i & 3); }

struct Unit { int pm, pn; };
struct Gemm { const bf16_t* A; const bf16_t* Bt; int M, N, K; int asplit; size_t astride; };

struct StaticOrder {
    int nM, nN, nwg, G, c;
    __host__ __device__ void init(int M, int N, int G_, int c_) { nM = M / BM; nN = N / BM; nwg = nM * nN; G = G_; c = c_; }
    __host__ __device__ bool next(int i, Unit& u) const {
        const long L = (long)i * G + c; if (L >= nwg) return false;
        int wgid = (int)L; { const int q = nwg / NXCD, r = nwg % NXCD, xcd = wgid % NXCD, off = wgid / NXCD; wgid = (xcd < r ? xcd * (q + 1) : r * (q + 1) + (xcd - r) * q) + off; }
        const int nig = WGM * nN, gid = wgid / nig, fm = gid * WGM, gsz = (nM - fm) < WGM ? (nM - fm) : WGM;
        u.pm = fm + ((wgid % nig) % gsz); u.pn = (wgid % nig) / gsz; return true;
    }
    __device__ __forceinline__ void a_ready(const Unit&) const {}
    __device__ __forceinline__ void done(const Unit&) const {}
};

__device__ __forceinline__ unsigned cvt_pk_bf16(float lo, float hi) { unsigned r; asm volatile("v_cvt_pk_bf16_f32 %0, %1, %2" : "=v"(r) : "v"(lo), "v"(hi)); return r; }
typedef float f32x2 __attribute__((ext_vector_type(2)));
template <class Epi, class Sched, bool ALIGN_EPI = false, bool SP2 = false>
__device__ __forceinline__ void gemm_phase(PG8_LAS unsigned char* lds, const Gemm g, const Sched& S, const Epi& E) {
    const int tid = tidx(), wid = __builtin_amdgcn_readfirstlane(tid >> 6), lane = tid & 63, wr = wid >> 2, wc = wid & 3, fr = lane & 15, fq = lane >> 4;
    const int K = g.K, nt = K / BK;
    unsigned voffA[2], voffB[2];
#pragma unroll
    for (int i = 0; i < 2; ++i) { int R, C; stage_rc(tid * 16 + i * 8192, R, C); const int Rb = Epi::PERM ? ((R & ~31) + perm32(R & 31)) : R;
        voffA[i] = (unsigned)(R * K + C) * 2u; voffB[i] = (unsigned)(Rb * K + C) * 2u; }
    const size_t kstep = (size_t)(BK * 2);
    const size_t hstep = (size_t)HALF * K * 2;
    const size_t tstep = 2 * hstep;
    const unsigned ldsw = (unsigned)wid * 1024u;
    const int aoff = lds_byte(wr * 64 + fr, fq * 8), boff = lds_byte(wc * 32 + fr, fq * 8);
#define PG8_SA(b, h) (((b) * 2 + (h)) * HTB)
#define PG8_SB(b, h) ((4 + (b) * 2 + (h)) * HTB)
#define PG8_STAGE(bufoff, gbase, voff) do { _Pragma("unroll") for (int _i = 0; _i < 2; ++_i) \
        __builtin_amdgcn_global_load_lds((const unsigned*)((const char*)(gbase) + (voff)[_i]), (PG8_LAS unsigned*)(lds + (bufoff) + ldsw + _i * 8192), 16, 0, 0); } while (0)
#define PG8_LDA(dst, b, h) do { _Pragma("unroll") for (int m = 0; m < 4; ++m) _Pragma("unroll") for (int k = 0; k < 2; ++k) dst[m][k] = *(const PG8_LAS bf16x8*)(lds + PG8_SA(b, h) + aoff + m * 2048 + k * 1024); } while (0)
#define PG8_LDB(dst, b, h) do { _Pragma("unroll") for (int n = 0; n < 2; ++n) _Pragma("unroll") for (int k = 0; k < 2; ++k) dst[n][k] = *(const PG8_LAS bf16x8*)(lds + PG8_SB(b, h) + boff + n * 2048 + k * 1024); } while (0)
#define PG8_MMA(ai, bj, At, Bt) do { __builtin_amdgcn_s_setprio(1); _Pragma("unroll") for (int m = 0; m < 4; ++m) _Pragma("unroll") for (int n = 0; n < 2; ++n) _Pragma("unroll") for (int k = 0; k < 2; ++k) \
        acc[ai][bj][m][n] = __builtin_amdgcn_mfma_f32_16x16x32_bf16(Bt[n][k], At[m][k], acc[ai][bj][m][n], 0, 0, 0); __builtin_amdgcn_s_setprio(0); } while (0)
#define PG8_WAIT_V(n) asm volatile("s_waitcnt vmcnt(" #n ")" ::: "memory")
#define PG8_WAIT_L(n) asm volatile("s_waitcnt lgkmcnt(" #n ")" ::: "memory")
#define PG8_BAR __builtin_amdgcn_s_barrier()
#define PG8_SCHED __builtin_amdgcn_sched_barrier(0)
    Unit cur, nxt; int ui = 0;
    if (!S.next(0, cur)) return;
    f32x4 acc[2][2][4][2];
#pragma unroll
    for (int a = 0; a < 2; ++a)
#pragma unroll
        for (int b = 0; b < 2; ++b)
#pragma unroll
            for (int m = 0; m < 4; ++m)
#pragma unroll
                for (int n = 0; n < 2; ++n) acc[a][b][m][n] = (f32x4){0.f, 0.f, 0.f, 0.f};
    bf16x8 At[4][2], B0[2][2], B1[2][2];
    const char* cA = (const char*)g.A + (size_t)(cur.pn / g.asplit) * g.astride + (size_t)cur.pm * tstep; const char* cB = (const char*)g.Bt + (size_t)cur.pn * tstep;
    S.a_ready(cur);
    if constexpr (SP2) {
        PG8_STAGE(PG8_SB(0, 0), cB, voffB); PG8_STAGE(PG8_SB(0, 1), cB + hstep, voffB); PG8_STAGE(PG8_SA(0, 0), cA, voffA); PG8_STAGE(PG8_SA(0, 1), cA + hstep, voffA);
        if (wr == 1) PG8_BAR;
        PG8_WAIT_V(2); PG8_BAR;
        PG8_STAGE(PG8_SB(1, 0), cB + kstep, voffB); PG8_STAGE(PG8_SA(1, 0), cA + kstep, voffA); PG8_STAGE(PG8_SB(1, 1), cB + hstep + kstep, voffB);
        PG8_WAIT_V(6); PG8_BAR;
    } else {
        PG8_STAGE(PG8_SB(0, 0), cB, voffB); PG8_STAGE(PG8_SA(0, 0), cA, voffA); PG8_STAGE(PG8_SB(0, 1), cB + hstep, voffB); PG8_STAGE(PG8_SA(0, 1), cA + hstep, voffA);
        if (wr == 1) PG8_BAR;
        PG8_WAIT_V(4); PG8_BAR;
        PG8_STAGE(PG8_SB(1, 0), cB + kstep, voffB); PG8_STAGE(PG8_SA(1, 0), cA + kstep, voffA); PG8_STAGE(PG8_SB(1, 1), cB + hstep + kstep, voffB);
        PG8_WAIT_V(6); PG8_BAR;
    }
    for (;;) {
        const bool has_next = S.next(ui + 1, nxt);
        const char* nA = has_next ? (const char*)g.A + (size_t)(nxt.pn / g.asplit) * g.astride + (size_t)nxt.pm * tstep : cA; const char* nB = has_next ? (const char*)g.Bt + (size_t)nxt.pn * tstep : cB;
        for (int t = 0; t < nt; t += 2) {
            const bool last = (t == nt - 2);
            const char* a1 = cA + (size_t)(t + 1) * kstep;
            const char* a2 = last ? nA : cA + (size_t)(t + 2) * kstep; const char* b2 = last ? nB : cB + (size_t)(t + 2) * kstep;
            const char* a3 = a2 + kstep; const char* b3 = b2 + kstep;
            if (last && has_next) S.a_ready(nxt);
            if constexpr (SP2) {
            PG8_LDB(B0, 0, 0); PG8_LDB(B1, 0, 1); PG8_SCHED; PG8_LDA(At, 0, 0); PG8_STAGE(PG8_SA(1, 1), a1 + hstep, voffA);
            PG8_WAIT_V(8); PG8_WAIT_L(0); PG8_BAR; PG8_MMA(0, 0, At, B0); PG8_MMA(0, 1, At, B1); PG8_BAR; PG8_SCHED;
            PG8_LDA(At, 0, 1); PG8_STAGE(PG8_SB(0, 0), b2, voffB); PG8_STAGE(PG8_SB(0, 1), b2 + hstep, voffB); PG8_STAGE(PG8_SA(0, 0), a2, voffA);
            PG8_WAIT_V(8); PG8_WAIT_L(0); PG8_BAR; PG8_MMA(1, 0, At, B0); PG8_MMA(1, 1, At, B1); PG8_BAR; PG8_SCHED;
            PG8_LDB(B0, 1, 0); PG8_LDB(B1, 1, 1); PG8_SCHED; PG8_LDA(At, 1, 0); PG8_STAGE(PG8_SA(0, 1), a2 + hstep, voffA);
            PG8_WAIT_V(8); PG8_WAIT_L(0); PG8_BAR; PG8_MMA(0, 0, At, B0); PG8_MMA(0, 1, At, B1); PG8_BAR; PG8_SCHED;
            PG8_LDA(At, 1, 1); PG8_STAGE(PG8_SB(1, 0), b3, voffB); PG8_STAGE(PG8_SB(1, 1), b3 + hstep, voffB); PG8_STAGE(PG8_SA(1, 0), a3, voffA);
            PG8_WAIT_V(8); PG8_WAIT_L(0); PG8_BAR; PG8_MMA(1, 0, At, B0); PG8_MMA(1, 1, At, B1); PG8_BAR; PG8_SCHED;
            } else {
            PG8_LDB(B0, 0, 0); PG8_SCHED; PG8_LDA(At, 0, 0); PG8_STAGE(PG8_SA(1, 1), a1 + hstep, voffA);
            PG8_WAIT_L(8); PG8_BAR; PG8_WAIT_L(0); PG8_MMA(0, 0, At, B0); PG8_BAR; PG8_SCHED;
            PG8_LDB(B1, 0, 1); PG8_STAGE(PG8_SB(0, 0), b2, voffB);
            PG8_BAR; PG8_WAIT_L(0); PG8_MMA(0, 1, At, B1); PG8_BAR;
            PG8_LDA(At, 0, 1); PG8_STAGE(PG8_SA(0, 0), a2, voffA);
            PG8_BAR; PG8_WAIT_L(0); PG8_MMA(1, 0, At, B0); PG8_BAR; PG8_SCHED;
            PG8_STAGE(PG8_SB(0, 1), b2 + hstep, voffB);
            PG8_WAIT_V(6); PG8_BAR; PG8_MMA(1, 1, At, B1); PG8_BAR;
            PG8_LDB(B0, 1, 0); PG8_SCHED; PG8_LDA(At, 1, 0); PG8_STAGE(PG8_SA(0, 1), a2 + hstep, voffA);
            PG8_WAIT_L(8); PG8_BAR; PG8_WAIT_L(0); PG8_MMA(0, 0, At, B0); PG8_BAR; PG8_SCHED;
            PG8_LDB(B1, 1, 1); PG8_STAGE(PG8_SB(1, 0), b3, voffB);
            PG8_BAR; PG8_WAIT_L(0); PG8_MMA(0, 1, At, B1); PG8_BAR;
            PG8_LDA(At, 1, 1); PG8_STAGE(PG8_SA(1, 0), a3, voffA);
            PG8_BAR; PG8_WAIT_L(0); PG8_MMA(1, 0, At, B0); PG8_BAR; PG8_SCHED;
            PG8_STAGE(PG8_SB(1, 1), b3 + hstep, voffB);
            PG8_WAIT_V(6); PG8_BAR; PG8_MMA(1, 1, At, B1); PG8_BAR;
            }
        }
        if constexpr (ALIGN_EPI) { if (wr == 0) PG8_BAR; }
        if constexpr (!Epi::AFTER_DRAIN) { E(acc, cur, wr, wc, fr, fq); S.done(cur); }
        if (!has_next) break;
#pragma unroll
        for (int a = 0; a < 2; ++a)
#pragma unroll
            for (int b = 0; b < 2; ++b)
#pragma unroll
                for (int m = 0; m < 4; ++m)
#pragma unroll
                    for (int n = 0; n < 2; ++n) acc[a][b][m][n] = (f32x4){0.f, 0.f, 0.f, 0.f};
        cur = nxt; cA = nA; cB = nB; ++ui;
        if constexpr (ALIGN_EPI) { if (wr == 1) PG8_BAR; }
    }
    PG8_WAIT_V(0);
    if constexpr (!ALIGN_EPI) { if (wr == 0) PG8_BAR; }
    PG8_BAR;
    if constexpr (Epi::AFTER_DRAIN) { E.fused(acc, cur, wr, wc, fr, fq, lds, wid, lane); S.done(cur); }
#undef PG8_SA
#undef PG8_SB
#undef PG8_STAGE
#undef PG8_LDA
#undef PG8_LDB
#undef PG8_MMA
#undef PG8_WAIT_V
#undef PG8_WAIT_L
#undef PG8_BAR
#undef PG8_SCHED
}
}

using pg8::bf16_t; using pg8::f32x4; using pg8::bf16x8; using pg8::u32x4;
#define LAS __attribute__((address_space(3)))
typedef unsigned u32x2 __attribute__((ext_vector_type(2)));
typedef float f32x2 __attribute__((ext_vector_type(2)));

constexpr int M = 32768, D = 1024, SEQ = 2048, NB = 16, DR = 1344, DP = 1536, FF = 4096, MEMT = 256, MM = NB * MEMT;
constexpr float ALPHA = 1.6817928305074290f, LN_EPS = 1e-5f, LOG2E = 1.4426950408889634f;
constexpr size_t MiB = 1u << 20;
constexpr size_t WS_WC = 1 * MiB, WS_MEMB = 25 * MiB, WS_WM = 33 * MiB, WS_HB = 53 * MiB, WS_S = 117 * MiB, WS_END = 501 * MiB;
constexpr size_t WC_Q = 0, WC_K = 2 * MiB, WC_V = 4 * MiB, WC_O = 6 * MiB, WC_W1 = 8 * MiB, WC_W2 = 16 * MiB;
constexpr int LDS_BYTES = 147456;
constexpr int NPHASE = 53;

__device__ __forceinline__ unsigned f2bf(float f) { unsigned u = __builtin_bit_cast(unsigned, f); return (u + 0x7fffu + ((u >> 16) & 1u)) >> 16; }
__device__ __forceinline__ unsigned pk2(float lo, float hi) { return f2bf(lo) | (f2bf(hi) << 16); }
__device__ __forceinline__ float bflo(unsigned u) { return __uint_as_float(u << 16); }
__device__ __forceinline__ float bfhi(unsigned u) { return __uint_as_float(u & 0xffff0000u); }
__device__ __forceinline__ float sigmoid_(float x) { return 1.0f / (1.0f + __expf(-x)); }
__device__ __forceinline__ float softplus_(float x) { return fmaxf(x, 0.f) + __logf(1.0f + __expf(-fabsf(x))); }
__device__ __forceinline__ float tanh_(float x) { return 1.0f - 2.0f / (1.0f + __expf(2.0f * x)); }
__device__ __forceinline__ float gelu_tanh_(float x) { return 0.5f * x * (1.0f + tanh_(0.7978845608028654f * (x + 0.044715f * x * x * x))); }

struct EpiP { bf16_t* O; bf16_t* O2; int ldc; const float* p0; const float* p1; float scale; int scale_cols; };
template <int MODE> struct EpiT {
    static constexpr bool PERM = true, AFTER_DRAIN = false; EpiP P;
    __device__ __forceinline__ void operator()(const f32x4 (&acc)[2][2][4][2], const pg8::Unit& u, int wr, int wc, int fr, int fq) const {
        const int row0 = u.pm * 256 + wr * 64 + fr;
#pragma unroll
        for (int bj = 0; bj < 2; ++bj) {
            const int col = u.pn * 256 + bj * 128 + wc * 32 + 8 * fq;
            float bias[8];
#pragma unroll
            for (int e = 0; e < 8; ++e) bias[e] = 0.f;
            bf16_t* base = P.O; int ocol = col; float sc = 1.f;
            if (MODE == 0) { sc = (col < P.scale_cols) ? P.scale : 1.f; }
            if (MODE == 1) { if (col >= DP) { base = P.O2; ocol = col - DP; } }
            if (MODE == 2) { const int g = col / DP, cc = col - g * DP; if (cc < DR) {
#pragma unroll
                    for (int e = 0; e < 8; ++e) bias[e] = P.p0[g * DR + cc + e]; } }
            if (MODE == 4) { if (col < 2048) { const float* bp = (col < 1024) ? (P.p0 + col) : (P.p1 + (col - 1024));
#pragma unroll
                    for (int e = 0; e < 8; ++e) bias[e] = bp[e]; } }
#pragma unroll
            for (int ai = 0; ai < 2; ++ai)
#pragma unroll
                for (int m = 0; m < 4; ++m) {
                    const int row = row0 + ai * 128 + m * 16;
                    float v[8];
#pragma unroll
                    for (int e = 0; e < 4; ++e) { v[e] = acc[ai][bj][m][0][e]; v[4 + e] = acc[ai][bj][m][1][e]; }
#pragma unroll
                    for (int e = 0; e < 8; ++e) {
                        float x = v[e] + bias[e];
                        if (MODE == 0) x *= sc;
                        if (MODE == 1) { if (col < DP) x = gelu_tanh_(x); }
                        if (MODE == 2) x = sigmoid_(x);
                        if (MODE == 3) { if (col < 64) x = tanh_(x); else if (col >= 128) x = sigmoid_(x); }
                        if (MODE == 4) { if (col < 1024) { const float wl = -softplus_(-x) - 0.5f; x = -__expf(wl); } else if (col < 2048) x = sigmoid_(x); }
                        if (MODE == 5) { x = fmaxf(x, 0.f); x = x * x; }
                        v[e] = x;
                    }
                    u32x4 w; w.x = pg8::cvt_pk_bf16(v[0], v[1]); w.y = pg8::cvt_pk_bf16(v[2], v[3]); w.z = pg8::cvt_pk_bf16(v[4], v[5]); w.w = pg8::cvt_pk_bf16(v[6], v[7]);
                    *(u32x4*)(base + (size_t)row * P.ldc + ocol) = w;
                    asm volatile("" ::: "memory");
                }
        }
    }
};
struct EpiRes {
    static constexpr bool PERM = true, AFTER_DRAIN = false; float* out;
    __device__ __forceinline__ void operator()(const f32x4 (&acc)[2][2][4][2], const pg8::Unit& u, int wr, int wc, int fr, int fq) const {
        const int row0 = u.pm * 256 + wr * 64 + fr;
#pragma unroll
        for (int bj = 0; bj < 2; ++bj) {
            const int col = u.pn * 256 + bj * 128 + wc * 32 + 8 * fq;
#pragma unroll
            for (int ai = 0; ai < 2; ++ai)
#pragma unroll
                for (int m = 0; m < 4; ++m) {
                    float* p = out + (size_t)(row0 + ai * 128 + m * 16) * D + col;
                    f32x4 b0 = *(const f32x4*)p, b1 = *(const f32x4*)(p + 4);
                    b0 = b0 * ALPHA + acc[ai][bj][m][0]; b1 = b1 * ALPHA + acc[ai][bj][m][1];
                    *(f32x4*)p = b0; *(f32x4*)(p + 4) = b1;
                    if (m & 1) asm volatile("" ::: "memory");
                }
        }
    }
};

template <class Epi> __device__ __forceinline__ void run_gemm(LAS unsigned char* lds, const bf16_t* A, const bf16_t* Bt, int M_, int N_, int K_, int asplit, size_t astride, const Epi& E) {
    asm volatile("" : "+s"(K_));
    pg8::Gemm g{A, Bt, M_, N_, K_, asplit, astride}; pg8::StaticOrder S; S.init(M_, N_, gdim(), bidx());
    pg8::gemm_phase<Epi, pg8::StaticOrder, true, true>(lds, g, S, E);
}

__device__ __forceinline__ void tr_item(const float* W, int ldn, int c0, int N, bf16_t* WT, int ldw, int row_off, int koff, LAS float* scr, int item, int lane) {
    const int nblk = N / 32, kb = item / nblk, nb = item % nblk, k0 = 64 * kb, n0 = 32 * nb;
#pragma unroll 8
    for (int i = 0; i < 32; ++i) { const int kk = 2 * i + (lane >> 5); scr[kk * 33 + (lane & 31)] = W[(size_t)(k0 + kk) * ldn + c0 + n0 + (lane & 31)]; }
    asm volatile("s_waitcnt lgkmcnt(0)" ::: "memory");
    const int c = lane & 7;
#pragma unroll
    for (int j = 0; j < 4; ++j) { const int n = (lane >> 3) + 8 * j; const LAS float* s = scr + (8 * c) * 33 + n;
        u32x4 o; o.x = pk2(s[0 * 33], s[1 * 33]); o.y = pk2(s[2 * 33], s[3 * 33]); o.z = pk2(s[4 * 33], s[5 * 33]); o.w = pk2(s[6 * 33], s[7 * 33]);
        *(u32x4*)(WT + (size_t)(row_off + n0 + n) * ldw + koff + k0 + 8 * c) = o; }
    asm volatile("s_waitcnt lgkmcnt(0)" ::: "memory");
}
#define TRJOB(W, ldn, c0, K, N, WT, ldw, roff, koff) { const int cnt_ = ((K) / 64) * ((N) / 32); if (r < cnt_) { tr_item(W, ldn, c0, N, WT, ldw, roff, koff, scr, r, lane); continue; } r -= cnt_; }

struct Args { const float* in[37]; float* out; unsigned char* ws; int lo, hi; };
constexpr int TAB_OFF = 131072 + 1024;
__device__ __forceinline__ const float* ldp(LAS unsigned char* lds, int i) {
    volatile LAS unsigned* t = (volatile LAS unsigned*)(lds + TAB_OFF) + 2 * i;
    const unsigned lo = (unsigned)__builtin_amdgcn_readfirstlane((int)t[0]), hi = (unsigned)__builtin_amdgcn_readfirstlane((int)t[1]);
    return (const float*)(((unsigned long long)hi << 32) | (unsigned long long)lo);
}
#define IN(i) ldp(lds, (i))
#define WSP ((unsigned char*)ldp(lds, 38))
#define OUTP ((float*)ldp(lds, 37))

__device__ __forceinline__ void convert_layer(int L, LAS unsigned char* lds) {
    const int tid = tidx(), lane = tid & 63, wave = tid >> 6;
    const int gw = bidx() * 8 + wave, NGW = gdim() * 8;
    LAS float* scr = (LAS float*)(lds + wave * 16384);
    unsigned char* wsp_ = WSP; bf16_t* WC = (bf16_t*)(wsp_ + WS_WC); bf16_t* WM = (bf16_t*)(wsp_ + WS_WM);
    const int kind = L % 3, j = L / 3;
    const float* wq = IN(32) + (size_t)L * D * D; const float* wkv = IN(33) + (size_t)L * D * 2 * D; const float* wo = IN(34) + (size_t)L * D * D;
    const float* w1 = IN(35) + (size_t)L * D * FF; const float* w2 = IN(36) + (size_t)L * FF * D;
    for (int it = gw;; it += NGW) {
        int r = it;
        TRJOB(wq, D, 0, D, D, WC + WC_Q / 2, D, 0, 0)
        TRJOB(wkv, 2 * D, 0, D, D, WC + WC_K / 2, D, 0, 0)
        TRJOB(wkv, 2 * D, D, D, D, WC + WC_V / 2, D, 0, 0)
        TRJOB(wo, D, 0, D, D, WC + WC_O / 2, D, 0, 0)
        TRJOB(w1, FF, 0, D, FF, WC + WC_W1 / 2, D, 0, 0)
        TRJOB(w2, D, 0, FF, D, WC + WC_W2 / 2, FF, 0, 0)
        if (kind == 0) {
            const float* win = IN(4) + (size_t)j * D * 2 * DR; const float* wout = IN(10) + (size_t)j * DR * D;
            TRJOB(win, 2 * DR, 0, D, DR, WM, D, 0, 0)
            TRJOB(win, 2 * DR, DR, D, DR, WM, D, DP, 0)
            TRJOB(wout, D, 0, DR, D, WM + 15 * MiB / 2, DP, 0, 0)
        } else if (kind == 1) {
            const float* wr = IN(12) + (size_t)j * D * D; const float* wk = IN(13) + (size_t)j * D * D; const float* wv = IN(14) + (size_t)j * D * D; const float* wo2 = IN(28) + (size_t)j * D * D;
            TRJOB(wr, D, 0, D, D, WM, D, 0, 0)
            TRJOB(wk, D, 0, D, D, WM, D, D, 0)
            TRJOB(wv, D, 0, D, D, WM, D, 2 * D, 0)
            TRJOB(wo2, D, 0, D, D, WM + 10 * MiB / 2, D, 0, 0)
        } else {
            const float* wqkv = IN(29) + (size_t)j * D * 3 * D; const float* wo2 = IN(31) + (size_t)j * D * D;
            TRJOB(wqkv, 3 * D, 0, D, 2 * D, WM, D, 0, 0)
            TRJOB(wqkv, 3 * D, 2 * D, D, D, WM + 4 * MiB / 2, D, 0, 0)
            TRJOB(wo2, D, 0, D, D, WM + 6 * MiB / 2, D, 0, 0)
        }
        break;
    }
    const int gt = bidx() * 512 + tid, NGT = gdim() * 512;
    if (kind == 0) {
        const float* gwt = IN(7) + (size_t)j * 2 * 16 * 84 * 84;
        bf16_t* GW = WM + 6 * MiB / 2;
        for (int idx = gt; idx < 3072 * (DP / 8); idx += NGT) {
            const int n = idx / (DP / 8), k0 = (idx % (DP / 8)) * 8; const int g = n / DP, cc = n % DP; float v[8];
#pragma unroll
            for (int e = 0; e < 8; ++e) { const int k = k0 + e; v[e] = (cc < DR && k < DR && (cc / 84) == (k / 84)) ? gwt[(((size_t)g * 16 + cc / 84) * 84 + (k % 84)) * 84 + (cc % 84)] : 0.f; }
            u32x4 o; o.x = pk2(v[0], v[1]); o.y = pk2(v[2], v[3]); o.z = pk2(v[4], v[5]); o.w = pk2(v[6], v[7]);
            *(u32x4*)(GW + (size_t)n * DP + k0) = o;
        }
        for (int idx = gt; idx < 2 * 192 * (D / 8); idx += NGT) {
            const int rr = idx / (D / 8), k0 = (idx % (D / 8)) * 8; const int n = (rr < 192) ? (DR + rr) : (DP + DR + rr - 192);
            *(u32x4*)(WM + (size_t)n * D + k0) = (u32x4){0u, 0u, 0u, 0u};
        }
        bf16_t* WOUT = WM + 15 * MiB / 2;
        for (int idx = gt; idx < D * 24; idx += NGT) {
            const int n = idx / 24, k0 = DR + (idx % 24) * 8;
            *(u32x4*)(WOUT + (size_t)n * DP + k0) = (u32x4){0u, 0u, 0u, 0u};
        }
    } else if (kind == 1) {
        const float* w1_ = IN(16) + (size_t)j * D * 64; const float* a1_ = IN(19) + (size_t)j * D * 64; const float* g1_ = IN(21) + (size_t)j * D * 128;
        const float* w2_ = IN(17) + (size_t)j * 64 * D; const float* a2_ = IN(20) + (size_t)j * 64 * D; const float* g2_ = IN(22) + (size_t)j * 128 * D;
        bf16_t* WL1 = WM + 6 * MiB / 2; bf16_t* WL2 = WM + 8 * MiB / 2;
        for (int idx = gt; idx < 256 * (3072 / 8); idx += NGT) {
            const int n = idx / 384, k0 = (idx % 384) * 8; float v[8];
#pragma unroll
            for (int e = 0; e < 8; ++e) { const int k = k0 + e; float x = 0.f;
                if (n < 64) { if (k < 1024) x = w1_[(size_t)k * 64 + n]; }
                else if (n < 128) { if (k >= 1024 && k < 2048) x = a1_[(size_t)(k - 1024) * 64 + (n - 64)]; }
                else { if (k >= 2048) x = g1_[(size_t)(k - 2048) * 128 + (n - 128)]; }
                v[e] = x; }
            u32x4 o; o.x = pk2(v[0], v[1]); o.y = pk2(v[2], v[3]); o.z = pk2(v[4], v[5]); o.w = pk2(v[6], v[7]);
            *(u32x4*)(WL1 + (size_t)n * 3072 + k0) = o;
        }
        for (int idx = gt; idx < 3072 * 32; idx += NGT) {
            const int n = idx / 32, k0 = (idx % 32) * 8; float v[8];
#pragma unroll
            for (int e = 0; e < 8; ++e) { const int k = k0 + e; float x = 0.f;
                if (n < 1024) { if (k < 64) x = w2_[(size_t)k * D + n]; }
                else if (n < 2048) { if (k >= 64 && k < 128) x = a2_[(size_t)(k - 64) * D + (n - 1024)]; }
                else { if (k >= 128) x = g2_[(size_t)(k - 128) * D + (n - 2048)]; }
                v[e] = x; }
            u32x4 o; o.x = pk2(v[0], v[1]); o.y = pk2(v[2], v[3]); o.z = pk2(v[4], v[5]); o.w = pk2(v[6], v[7]);
            *(u32x4*)(WL2 + (size_t)n * 256 + k0) = o;
        }
    }
}

__device__ __forceinline__ void ln_phase(float* H, bf16_t* HB, const float* g, const float* b) {
    const int tid = tidx(), lane = tid & 63, wave = tid >> 6;
    const int gw = bidx() * 8 + wave, NGW = gdim() * 8;
    f32x4 gv[4], bv[4];
#pragma unroll
    for (int j = 0; j < 4; ++j) { gv[j] = *(const f32x4*)(g + 256 * j + 4 * lane); bv[j] = *(const f32x4*)(b + 256 * j + 4 * lane); }
    for (int m = gw; m < M; m += NGW) {
        float* row = H + (size_t)m * D + 4 * lane; f32x4 v[4]; float s = 0.f;
#pragma unroll
        for (int j = 0; j < 4; ++j) { v[j] = *(const f32x4*)(row + 256 * j); s += (v[j].x + v[j].y) + (v[j].z + v[j].w); }
#pragma unroll
        for (int o = 1; o < 64; o <<= 1) s += __shfl_xor(s, o);
        const float mean = s * (1.f / D); float s2 = 0.f;
#pragma unroll
        for (int j = 0; j < 4; ++j) { v[j] = v[j] - mean; s2 += (v[j].x * v[j].x + v[j].y * v[j].y) + (v[j].z * v[j].z + v[j].w * v[j].w); }
#pragma unroll
        for (int o = 1; o < 64; o <<= 1) s2 += __shfl_xor(s2, o);
        const float rstd = 1.f / sqrtf(s2 * (1.f / D) + LN_EPS);
        bf16_t* hb = HB + (size_t)m * D + 4 * lane;
#pragma unroll
        for (int j = 0; j < 4; ++j) { const f32x4 y = v[j] * rstd * gv[j] + bv[j]; *(f32x4*)(row + 256 * j) = y;
            u32x2 w; w.x = pk2(y.x, y.y); w.y = pk2(y.z, y.w); *(u32x2*)(hb + 256 * j) = w; }
    }
}

template <int HD, int NQT, bool BIAS>
__device__ __forceinline__ void attn_task(const bf16_t* Q, int ldq, const bf16_t* K, int ldk, const bf16_t* Vt, size_t ldv, int nkeys, bf16_t* O, int ldo,
                                          const float* relb, int qpos0, int kpos0, int lane) {
    const int l16 = lane & 15, fq = lane >> 4;
    bf16x8 qf[NQT][HD / 32];
#pragma unroll
    for (int t = 0; t < NQT; ++t)
#pragma unroll
        for (int ds = 0; ds < HD / 32; ++ds) qf[t][ds] = *(const bf16x8*)(Q + (size_t)(16 * t + l16) * ldq + 32 * ds + 8 * fq);
    f32x4 o[NQT][HD / 16]; float mrun[NQT], lsum[NQT];
#pragma unroll
    for (int t = 0; t < NQT; ++t) { mrun[t] = -INFINITY; lsum[t] = 0.f;
#pragma unroll
        for (int dt = 0; dt < HD / 16; ++dt) o[t][dt] = (f32x4){0.f, 0.f, 0.f, 0.f}; }
    float bfar = 0.f; if (BIAS) bfar = relb[256] * LOG2E;
    for (int key0 = 0; key0 < nkeys; key0 += 32) {
        f32x4 s[NQT][2];
#pragma unroll
        for (int t = 0; t < NQT; ++t) { s[t][0] = (f32x4){0.f, 0.f, 0.f, 0.f}; s[t][1] = (f32x4){0.f, 0.f, 0.f, 0.f}; }
        const bf16_t* kp = K + (size_t)(key0 + l16) * ldk + 8 * fq;
#pragma unroll
        for (int ds = 0; ds < HD / 32; ++ds) {
            const bf16x8 k0f = *(const bf16x8*)(kp + 32 * ds), k1f = *(const bf16x8*)(kp + (size_t)16 * ldk + 32 * ds);
#pragma unroll
            for (int t = 0; t < NQT; ++t) { s[t][0] = __builtin_amdgcn_mfma_f32_16x16x32_bf16(k0f, qf[t][ds], s[t][0], 0, 0, 0); s[t][1] = __builtin_amdgcn_mfma_f32_16x16x32_bf16(k1f, qf[t][ds], s[t][1], 0, 0, 0); }
        }
        bf16x8 pf[NQT];
        const bool farstep = BIAS && (qpos0 - (kpos0 + key0 + 31) >= 128);
#pragma unroll
        for (int t = 0; t < NQT; ++t) {
            float x[8];
#pragma unroll
            for (int kb = 0; kb < 2; ++kb)
#pragma unroll
                for (int e = 0; e < 4; ++e) {
                    float bb = 0.f;
                    if (BIAS) { if (farstep) bb = bfar; else { int rel = (qpos0 + 16 * t + l16) - (kpos0 + key0 + 16 * kb + 4 * fq + e); rel = rel < -128 ? -128 : (rel > 128 ? 128 : rel); bb = relb[rel + 128] * LOG2E; } }
                    x[4 * kb + e] = s[t][kb][e] * LOG2E + bb;
                }
            float mt = fmaxf(fmaxf(fmaxf(x[0], x[1]), fmaxf(x[2], x[3])), fmaxf(fmaxf(x[4], x[5]), fmaxf(x[6], x[7])));
            mt = fmaxf(mt, __shfl_xor(mt, 16)); mt = fmaxf(mt, __shfl_xor(mt, 32));
            const float mnew = fmaxf(mrun[t], mt), scl = __builtin_amdgcn_exp2f(mrun[t] - mnew); mrun[t] = mnew;
            float ps = 0.f;
#pragma unroll
            for (int e = 0; e < 8; ++e) { x[e] = __builtin_amdgcn_exp2f(x[e] - mnew); ps += x[e]; }
            lsum[t] = lsum[t] * scl + ps;
#pragma unroll
            for (int dt = 0; dt < HD / 16; ++dt) o[t][dt] = o[t][dt] * scl;
            u32x4 w; w.x = pg8::cvt_pk_bf16(x[0], x[1]); w.y = pg8::cvt_pk_bf16(x[2], x[3]); w.z = pg8::cvt_pk_bf16(x[4], x[5]); w.w = pg8::cvt_pk_bf16(x[6], x[7]);
            pf[t] = __builtin_bit_cast(bf16x8, w);
        }
        const bf16_t* vp = Vt + (size_t)l16 * ldv + key0 + 4 * fq;
#pragma unroll
        for (int dt = 0; dt < HD / 16; ++dt) {
            const u32x2 lo = *(const u32x2*)(vp + (size_t)(16 * dt) * ldv), hi = *(const u32x2*)(vp + (size_t)(16 * dt) * ldv + 16);
            const u32x4 vv = (u32x4){lo.x, lo.y, hi.x, hi.y}; const bf16x8 vf = __builtin_bit_cast(bf16x8, vv);
#pragma unroll
            for (int t = 0; t < NQT; ++t) o[t][dt] = __builtin_amdgcn_mfma_f32_16x16x32_bf16(vf, pf[t], o[t][dt], 0, 0, 0);
        }
    }
#pragma unroll
    for (int t = 0; t < NQT; ++t) {
        float l = lsum[t]; l += __shfl_xor(l, 16); l += __shfl_xor(l, 32); const float inv = 1.0f / l;
        bf16_t* op = O + (size_t)(16 * t + l16) * ldo + 4 * fq;
#pragma unroll
        for (int dt = 0; dt < HD / 16; ++dt) { const f32x4 v = o[t][dt] * inv; u32x2 w; w.x = pg8::cvt_pk_bf16(v[0], v[1]); w.y = pg8::cvt_pk_bf16(v[2], v[3]); *(u32x2*)(op + 16 * dt) = w; }
    }
}
__device__ __forceinline__ void chunk_attn_phase(const bf16_t* QK, const bf16_t* Vt, bf16_t* O, const float* relb) {
    const int tid = tidx(), lane = tid & 63, wave = tid >> 6;
    for (int task = bidx() * 8 + wave; task < 16384; task += gdim() * 8) {
        const int half = task & 1, c = (task >> 1) & 31, h = (task >> 6) & 15, b = task >> 10;
        const int kc0 = c > 8 ? c - 8 : 0;
        const size_t qrow = (size_t)b * SEQ + c * 64 + half * 32, krow = (size_t)b * SEQ + kc0 * 64;
        attn_task<64, 2, true>(QK + qrow * 2048 + h * 64, 2048, QK + krow * 2048 + 1024 + h * 64, 2048, Vt + (size_t)(h * 64) * M + krow, (size_t)M, (c + 1 - kc0) * 64,
                               O + qrow * D + h * 64, D, relb + h * 257, c * 64 + half * 32, kc0 * 64, lane);
    }
}
__device__ __forceinline__ void mem_attn_phase(const bf16_t* Qx, const bf16_t* Km, const bf16_t* Vtm, bf16_t* O) {
    const int tid = tidx(), lane = tid & 63, wave = tid >> 6;
    for (int task = bidx() * 8 + wave; task < 8192; task += gdim() * 8) {
        const int qt = task & 127, mh = (task >> 7) & 3, b = task >> 9;
        const size_t qrow = (size_t)b * SEQ + qt * 16;
        attn_task<256, 1, false>(Qx + qrow * D + mh * 256, D, Km + (size_t)(b * MEMT) * D + mh * 256, D, Vtm + (size_t)(mh * 256) * MM + b * MEMT, (size_t)MM, MEMT,
                                 O + qrow * D + mh * 256, D, nullptr, 0, 0, lane);
    }
}

__device__ __forceinline__ void conv_phase(const bf16_t* UX, bf16_t* XR, const float* cw, const float* cb) {
    const int gt = bidx() * 512 + tidx(), NGT = gdim() * 512;
    for (int idx = gt; idx < M * (DP / 8); idx += NGT) {
        const int m = idx / (DP / 8), c8 = (idx % (DP / 8)) * 8; u32x4 o = (u32x4){0u, 0u, 0u, 0u};
        if (c8 < DR) {
            const int t = m & (SEQ - 1); float acc[8];
#pragma unroll
            for (int e = 0; e < 8; ++e) acc[e] = cb[c8 + e];
#pragma unroll
            for (int k = 0; k < 4; ++k) { if (t - 3 + k >= 0) { const u32x4 u = *(const u32x4*)(UX + (size_t)(m - 3 + k) * DP + c8); const float* w = cw + k * DR + c8;
                    acc[0] += w[0] * bflo(u.x); acc[1] += w[1] * bfhi(u.x); acc[2] += w[2] * bflo(u.y); acc[3] += w[3] * bfhi(u.y);
                    acc[4] += w[4] * bflo(u.z); acc[5] += w[5] * bfhi(u.z); acc[6] += w[6] * bflo(u.w); acc[7] += w[7] * bfhi(u.w); } }
            o.x = pk2(acc[0], acc[1]); o.y = pk2(acc[2], acc[3]); o.z = pk2(acc[4], acc[5]); o.w = pk2(acc[6], acc[7]);
        }
        *(u32x4*)(XR + (size_t)m * DP + c8) = o;
    }
}
__device__ __forceinline__ void scan_phase(LAS unsigned char* lds, const bf16_t* GATES, const bf16_t* XR, bf16_t* UG, const float* lam) {
    const int tid = tidx(), ch = tid & 63, seg = tid >> 6;
    LAS float* sA = (LAS float*)lds; LAS float* sB = sA + 512;
    for (int unit = bidx(); unit < NB * 21; unit += gdim()) {
        const int b = unit / 21, c = (unit % 21) * 64 + ch;
        const float sp = 8.0f * softplus_(-lam[c]);
        const size_t m0 = (size_t)b * SEQ + seg * 256;
        float A = 1.f, B = 0.f;
#pragma unroll 4
        for (int t = 0; t < 256; ++t) {
            const size_t m = m0 + t;
            const float r = bflo(GATES[m * 3072 + c]), ig = bflo(GATES[m * 3072 + DP + c]), x = bflo(XR[m * DP + c]);
            const float la = -sp * r, av = __expf(la), bt = sqrtf(-expm1f(2.0f * la)) * (ig * x);
            B = av * B + bt; A *= av;
        }
        sA[seg * 64 + ch] = A; sB[seg * 64 + ch] = B;
        __syncthreads();
        float hh = 0.f;
        for (int s = 0; s < seg; ++s) hh = sA[s * 64 + ch] * hh + sB[s * 64 + ch];
#pragma unroll 4
        for (int t = 0; t < 256; ++t) {
            const size_t m = m0 + t;
            const float r = bflo(GATES[m * 3072 + c]), ig = bflo(GATES[m * 3072 + DP + c]), x = bflo(XR[m * DP + c]), ug = bflo(UG[m * DP + c]);
            const float la = -sp * r, av = __expf(la), bt = sqrtf(-expm1f(2.0f * la)) * (ig * x);
            hh = av * hh + bt;
            UG[m * DP + c] = (bf16_t)f2bf(hh * ug);
        }
        __syncthreads();
    }
}

__device__ __forceinline__ void prep_phase(const float* H, bf16_t* X, const float* mu, int mode) {
    const int gt = bidx() * 512 + tidx(), NGT = gdim() * 512;
    const int i0 = mode ? 0 : 1, i1 = mode ? 2 : 4, i2 = mode ? 3 : 5;
    for (int idx = gt; idx < M * (D / 8); idx += NGT) {
        const int m = idx >> 7, c8 = (idx & 127) * 8; const int t = m & (SEQ - 1);
        const float* hp = H + (size_t)m * D + c8;
        const f32x4 h0 = *(const f32x4*)hp, h1 = *(const f32x4*)(hp + 4);
        f32x4 p0 = (f32x4){0.f, 0.f, 0.f, 0.f}, p1 = p0;
        if (t > 0) { p0 = *(const f32x4*)(hp - D); p1 = *(const f32x4*)(hp - D + 4); }
        const f32x4 x0 = p0 - h0, x1 = p1 - h1;
#pragma unroll
        for (int q = 0; q < 3; ++q) {
            const int mi = q == 0 ? i0 : (q == 1 ? i1 : i2);
            const f32x4 m0 = *(const f32x4*)(mu + mi * D + c8), m1 = *(const f32x4*)(mu + mi * D + c8 + 4);
            const f32x4 y0 = h0 + x0 * m0, y1 = h1 + x1 * m1;
            u32x4 o; o.x = pk2(y0.x, y0.y); o.y = pk2(y0.z, y0.w); o.z = pk2(y1.x, y1.y); o.w = pk2(y1.z, y1.w);
            bf16_t* dst = mode ? (X + (size_t)q * M * D + (size_t)m * D + c8) : (X + (size_t)m * 3072 + q * D + c8);
            *(u32x4*)dst = o;
        }
    }
}
__device__ __forceinline__ void rwkv_rec_phase(LAS unsigned char* lds, const bf16_t* RKV, const bf16_t* DAG, bf16_t* YG, const float* k_k, const float* k_a, const float* r_k,
                                               const float* lnx_g, const float* lnx_b) {
    LAS float* sAA = (LAS float*)lds; LAS float* sBB = sAA + 1024; LAS float* sW = sAA + 2048; LAS float* sK = sAA + 3072; LAS float* sR = sAA + 4096; LAS float* sV = sAA + 5120; LAS float* sY = sAA + 6144;
    const int tid = tidx(), tt = tid >> 5, jp = tid & 31, ri = tid >> 3, cg8 = tid & 7;
    for (int unit = bidx(); unit < 256; unit += gdim()) {
        const int b = unit >> 4, h = unit & 15, hc = h * 64 + 2 * jp;
        const float kk0 = k_k[hc], kk1 = k_k[hc + 1], ka0 = k_a[hc], ka1 = k_a[hc + 1], rk0 = r_k[hc], rk1 = r_k[hc + 1];
        const float lg0 = lnx_g[hc], lg1 = lnx_g[hc + 1], lb0 = lnx_b[hc], lb1 = lnx_b[hc + 1];
        float st[8];
#pragma unroll
        for (int e = 0; e < 8; ++e) st[e] = 0.f;
        const size_t mbase = (size_t)b * SEQ;
        unsigned pr, pk, pv, pd, pa, pg;
        { const size_t m = mbase + tt; const bf16_t* p = RKV + m * 3072 + hc; const bf16_t* q = DAG + m * 3072 + hc;
          pr = *(const unsigned*)p; pk = *(const unsigned*)(p + 1024); pv = *(const unsigned*)(p + 2048); pd = *(const unsigned*)q; pa = *(const unsigned*)(q + 1024); pg = *(const unsigned*)(q + 2048); }
        for (int blk = 0; blk < SEQ / 16; ++blk) {
            const size_t m = mbase + blk * 16 + tt;
            const float r0 = bflo(pr), r1 = bfhi(pr), k0 = bflo(pk), k1 = bfhi(pk), v0 = bflo(pv), v1 = bfhi(pv);
            const float d0 = bflo(pd), d1 = bfhi(pd), a0 = bflo(pa), a1 = bfhi(pa), g0 = bflo(pg), g1 = bfhi(pg);
            const float q0 = k0 * kk0, q1 = k1 * kk1; float ss = q0 * q0 + q1 * q1;
#pragma unroll
            for (int o = 1; o < 32; o <<= 1) ss += __shfl_xor(ss, o);
            const float inv = 1.0f / fmaxf(sqrtf(ss), 1e-12f);
            const float n0 = q0 * inv, n1 = q1 * inv;
            const float kp0 = k0 * (1.0f + (a0 - 1.0f) * ka0), kp1 = k1 * (1.0f + (a1 - 1.0f) * ka1);
            float bon = r0 * kp0 * rk0 + r1 * kp1 * rk1;
#pragma unroll
            for (int o = 1; o < 32; o <<= 1) bon += __shfl_xor(bon, o);
            const int li = tt * 64 + 2 * jp;
            *(LAS f32x2*)(sAA + li) = (f32x2){-n0, -n1}; *(LAS f32x2*)(sBB + li) = (f32x2){n0 * a0, n1 * a1};
            *(LAS f32x2*)(sW + li) = (f32x2){__expf(d0), __expf(d1)}; *(LAS f32x2*)(sK + li) = (f32x2){kp0, kp1};
            *(LAS f32x2*)(sR + li) = (f32x2){r0, r1}; *(LAS f32x2*)(sV + li) = (f32x2){v0, v1};
            __syncthreads();
            if (blk + 1 < SEQ / 16) { const size_t m2 = m + 16; const bf16_t* p = RKV + m2 * 3072 + hc; const bf16_t* q = DAG + m2 * 3072 + hc;
                pr = *(const unsigned*)p; pk = *(const unsigned*)(p + 1024); pv = *(const unsigned*)(p + 2048); pd = *(const unsigned*)q; pa = *(const unsigned*)(q + 1024); pg = *(const unsigned*)(q + 2048); }
#pragma unroll 2
            for (int t2 = 0; t2 < 16; ++t2) {
                const int lo = t2 * 64 + 8 * cg8;
                const f32x4 aa0 = *(const LAS f32x4*)(sAA + lo), aa1 = *(const LAS f32x4*)(sAA + lo + 4), ww0 = *(const LAS f32x4*)(sW + lo), ww1 = *(const LAS f32x4*)(sW + lo + 4);
                const f32x4 bb0 = *(const LAS f32x4*)(sBB + lo), bb1 = *(const LAS f32x4*)(sBB + lo + 4), kx0 = *(const LAS f32x4*)(sK + lo), kx1 = *(const LAS f32x4*)(sK + lo + 4);
                const f32x4 rr0 = *(const LAS f32x4*)(sR + lo), rr1 = *(const LAS f32x4*)(sR + lo + 4); const float vi = sV[t2 * 64 + ri];
                float sa = (st[0] * aa0.x + st[1] * aa0.y) + (st[2] * aa0.z + st[3] * aa0.w) + (st[4] * aa1.x + st[5] * aa1.y) + (st[6] * aa1.z + st[7] * aa1.w);
                sa += __shfl_xor(sa, 1); sa += __shfl_xor(sa, 2); sa += __shfl_xor(sa, 4);
                st[0] = st[0] * ww0.x + sa * bb0.x + vi * kx0.x; st[1] = st[1] * ww0.y + sa * bb0.y + vi * kx0.y; st[2] = st[2] * ww0.z + sa * bb0.z + vi * kx0.z; st[3] = st[3] * ww0.w + sa * bb0.w + vi * kx0.w;
                st[4] = st[4] * ww1.x + sa * bb1.x + vi * kx1.x; st[5] = st[5] * ww1.y + sa * bb1.y + vi * kx1.y; st[6] = st[6] * ww1.z + sa * bb1.z + vi * kx1.z; st[7] = st[7] * ww1.w + sa * bb1.w + vi * kx1.w;
                float y = (st[0] * rr0.x + st[1] * rr0.y) + (st[2] * rr0.z + st[3] * rr0.w) + (st[4] * rr1.x + st[5] * rr1.y) + (st[6] * rr1.z + st[7] * rr1.w);
                y += __shfl_xor(y, 1); y += __shfl_xor(y, 2); y += __shfl_xor(y, 4);
                if (cg8 == 0) sY[t2 * 64 + ri] = y;
            }
            __syncthreads();
            const f32x2 yy = *(const LAS f32x2*)(sY + li);
            float sm = yy.x + yy.y;
#pragma unroll
            for (int o = 1; o < 32; o <<= 1) sm += __shfl_xor(sm, o);
            const float mean = sm * (1.0f / 64.0f), e0 = yy.x - mean, e1 = yy.y - mean; float vs = e0 * e0 + e1 * e1;
#pragma unroll
            for (int o = 1; o < 32; o <<= 1) vs += __shfl_xor(vs, o);
            const float rs = 1.0f / sqrtf(vs * (1.0f / 64.0f) + 64e-5f);
            const float o0 = ((e0 * rs) * lg0 + lb0 + bon * v0) * g0, o1 = ((e1 * rs) * lg1 + lb1 + bon * v1) * g1;
            *(unsigned*)(YG + m * D + hc) = pk2(o0, o1);
        }
        __syncthreads();
    }
}

#define HAS(x) ((OPMASK >> (x)) & 1u)
enum { OP_PRO, OP_WIN, OP_CONV, OP_GATES, OP_SCAN, OP_RES, OP_LN, OP_PREP, OP_L1, OP_PLAIN, OP_L2, OP_REC, OP_CATT, OP_XATT, OP_MLP1 };

__host__ __device__ __forceinline__ void decode_phase(int pc, int& L, int& s, int& kind, int& j, int& op, int& sub) {
    if (pc < 1) { L = 0; s = -1; } else if (pc < 14) { L = 0; s = pc - 1; } else if (pc < 29) { L = 1; s = pc - 14; } else if (pc < 40) { L = 2; s = pc - 29; } else { L = 3; s = pc - 40; }
    kind = L % 3; j = L / 3; const int mlen = kind == 0 ? 6 : (kind == 1 ? 8 : 4);
    sub = 0;
    if (s < 0) op = OP_PRO;
    else if (s < mlen) {
        if (kind == 0) { op = s == 0 ? OP_WIN : s == 1 ? OP_CONV : s == 2 ? OP_GATES : s == 3 ? OP_SCAN : s == 4 ? OP_RES : OP_LN; }
        else if (kind == 1) { op = s == 0 ? OP_PREP : s == 1 ? OP_L1 : s == 2 ? OP_PREP : s == 3 ? OP_PLAIN : s == 4 ? OP_L2 : s == 5 ? OP_REC : s == 6 ? OP_RES : OP_LN; sub = (s == 2) ? 1 : 0; }
        else { op = s == 0 ? OP_PLAIN : s == 1 ? OP_CATT : s == 2 ? OP_RES : OP_LN; sub = (s == 0) ? 1 : 0; }
    } else {
        const int cs = s - mlen;
        op = cs == 0 ? OP_PLAIN : cs == 1 ? OP_XATT : cs == 2 ? OP_RES : cs == 3 ? OP_LN : cs == 4 ? OP_MLP1 : cs == 5 ? OP_RES : OP_LN;
        sub = cs == 0 ? 2 : cs == 2 ? 1 : cs == 3 ? 1 : cs == 5 ? 2 : cs == 6 ? 2 : 0;
    }
}
template <unsigned OPMASK> __global__ void __launch_bounds__(512, 2) fwd(Args a0) {
    extern __shared__ __attribute__((aligned(16))) unsigned char lds_raw[];
    LAS unsigned char* lds = (LAS unsigned char*)lds_raw;
    cg::grid_group grid = cg::this_grid();
    const int plo = a0.lo, phi = a0.hi;
    if (tidx() == 0) {
        LAS unsigned long long* tab = (LAS unsigned long long*)(lds + TAB_OFF);
#pragma unroll
        for (int i = 0; i < 37; ++i) tab[i] = (unsigned long long)a0.in[i];
        tab[37] = (unsigned long long)a0.out; tab[38] = (unsigned long long)a0.ws;
    }
    __syncthreads();
    for (int pc = plo; pc < phi; ++pc) {
        if (pc > plo) grid.sync();
        unsigned char* ws = WSP; float* H = OUTP;
        bf16_t* WC = (bf16_t*)(ws + WS_WC); bf16_t* MEMB = (bf16_t*)(ws + WS_MEMB); bf16_t* WM = (bf16_t*)(ws + WS_WM); bf16_t* HB = (bf16_t*)(ws + WS_HB);
        unsigned char* S = ws + WS_S;
        int L, s, kind, j, op, sub; decode_phase(pc, L, s, kind, j, op, sub);

        if (HAS(OP_PRO) && op == OP_PRO) {
            const int gt = bidx() * 512 + tidx(), NGT = gdim() * 512;
            const float* x = IN(0); const float* mem = IN(1);
            for (int idx = gt; idx < M * D / 8; idx += NGT) { const f32x4 v0 = *(const f32x4*)(x + (size_t)idx * 8), v1 = *(const f32x4*)(x + (size_t)idx * 8 + 4);
                *(f32x4*)(H + (size_t)idx * 8) = v0; *(f32x4*)(H + (size_t)idx * 8 + 4) = v1;
                u32x4 o; o.x = pk2(v0.x, v0.y); o.y = pk2(v0.z, v0.w); o.z = pk2(v1.x, v1.y); o.w = pk2(v1.z, v1.w); *(u32x4*)(HB + (size_t)idx * 8) = o; }
            for (int idx = gt; idx < MM * D / 8; idx += NGT) { const f32x4 v0 = *(const f32x4*)(mem + (size_t)idx * 8), v1 = *(const f32x4*)(mem + (size_t)idx * 8 + 4);
                u32x4 o; o.x = pk2(v0.x, v0.y); o.y = pk2(v0.z, v0.w); o.z = pk2(v1.x, v1.y); o.w = pk2(v1.z, v1.w); *(u32x4*)(MEMB + (size_t)idx * 8) = o; }
            convert_layer(0, lds);
        }
        else if (HAS(OP_WIN) && op == OP_WIN) {
            EpiT<1> E{{(bf16_t*)S, (bf16_t*)(S + 192 * MiB), DP, nullptr, nullptr, 1.f, 0}};
            run_gemm(lds, HB, WM, M, 2 * DP, D, 1 << 30, 0, E);
        }
        else if (HAS(OP_CONV) && op == OP_CONV) { conv_phase((const bf16_t*)(S + 192 * MiB), (bf16_t*)(S + 96 * MiB), IN(5) + (size_t)j * 4 * DR, IN(6) + (size_t)j * DR); }
        else if (HAS(OP_GATES) && op == OP_GATES) {
            EpiT<2> E{{(bf16_t*)(S + 192 * MiB), nullptr, 2 * DP, IN(8) + (size_t)j * 2 * DR, nullptr, 1.f, 0}};
            run_gemm(lds, (const bf16_t*)(S + 96 * MiB), WM + 6 * MiB / 2, M, 2 * DP, DP, 1 << 30, 0, E);
        }
        else if (HAS(OP_SCAN) && op == OP_SCAN) { scan_phase(lds, (const bf16_t*)(S + 192 * MiB), (const bf16_t*)(S + 96 * MiB), (bf16_t*)S, IN(9) + (size_t)j * DR); }
        else if (HAS(OP_RES) && op == OP_RES) {
            const bf16_t* A; const bf16_t* Bt; int K;
            if (sub == 0) {
                if (kind == 0) { A = (const bf16_t*)S; Bt = WM + 15 * MiB / 2; K = DP; }
                else if (kind == 1) { A = HB; Bt = WM + 10 * MiB / 2; K = D; }
                else { A = (const bf16_t*)(S + 192 * MiB); Bt = WM + 6 * MiB / 2; K = D; }
            } else if (sub == 1) { A = (const bf16_t*)(S + 64 * MiB); Bt = WC + WC_O / 2; K = D; }
            else { A = (const bf16_t*)S; Bt = WC + WC_W2 / 2; K = FF; }
            EpiRes E{H};
            run_gemm(lds, A, Bt, M, D, K, 1 << 30, 0, E);
        }
        else if (HAS(OP_LN) && op == OP_LN) {
            ln_phase(H, HB, IN(2) + (size_t)(L * 3 + sub) * D, IN(3) + (size_t)(L * 3 + sub) * D);
            if (sub == 2 && L < 3) convert_layer(L + 1, lds);
        }
        else if (HAS(OP_PREP) && op == OP_PREP) { prep_phase(H, (bf16_t*)S, IN(11) + (size_t)j * 6 * D, sub); }
        else if (HAS(OP_L1) && op == OP_L1) {
            EpiT<3> E{{HB, nullptr, 256, nullptr, nullptr, 1.f, 0}};
            run_gemm(lds, (const bf16_t*)S, WM + 6 * MiB / 2, M, 256, 3 * D, 1 << 30, 0, E);
        }
        else if (HAS(OP_L2) && op == OP_L2) {
            EpiT<4> E{{(bf16_t*)S, nullptr, 3 * D, IN(15) + (size_t)j * D, IN(18) + (size_t)j * D, 1.f, 0}};
            run_gemm(lds, HB, WM + 8 * MiB / 2, M, 3 * D, 256, 1 << 30, 0, E);
        }
        else if (HAS(OP_REC) && op == OP_REC) { rwkv_rec_phase(lds, (const bf16_t*)(S + 192 * MiB), (const bf16_t*)S, HB, IN(23) + (size_t)j * D, IN(24) + (size_t)j * D, IN(25) + (size_t)j * D, IN(26) + (size_t)j * D, IN(27) + (size_t)j * D); }
        else if (HAS(OP_PLAIN) && op == OP_PLAIN) {
            const int ng = sub == 0 ? 1 : (sub == 1 ? 2 : 3);
            for (int g = 0; g < ng; ++g) {
                const bf16_t* A; const bf16_t* Bt; int M_, N_, asplit = 1 << 30; size_t astride = 0; EpiP P{nullptr, nullptr, 0, nullptr, nullptr, 1.f, 0};
                if (sub == 0) { A = (const bf16_t*)S; Bt = WM; M_ = M; N_ = 3 * D; asplit = 4; astride = (size_t)M * D * 2; P.O = (bf16_t*)(S + 192 * MiB); P.ldc = 3 * D; }
                else if (sub == 1) {
                    if (g == 0) { A = HB; Bt = WM; M_ = M; N_ = 2 * D; P.O = (bf16_t*)S; P.ldc = 2 * D; P.scale = 0.125f; P.scale_cols = D; }
                    else { A = WM + 4 * MiB / 2; Bt = HB; M_ = D; N_ = M; P.O = (bf16_t*)(S + 128 * MiB); P.ldc = M; }
                } else {
                    if (g == 0) { A = HB; Bt = WC + WC_Q / 2; M_ = M; N_ = D; P.O = (bf16_t*)S; P.ldc = D; P.scale = 0.0625f; P.scale_cols = D; }
                    else if (g == 1) { A = MEMB; Bt = WC + WC_K / 2; M_ = MM; N_ = D; P.O = WM; P.ldc = D; }
                    else { A = WC + WC_V / 2; Bt = MEMB; M_ = D; N_ = MM; P.O = WM + 8 * MiB / 2; P.ldc = MM; }
                }
                EpiT<0> E{P};
                run_gemm(lds, A, Bt, M_, N_, D, asplit, astride, E);
            }
        }
        else if (HAS(OP_CATT) && op == OP_CATT) { chunk_attn_phase((const bf16_t*)S, (const bf16_t*)(S + 128 * MiB), (bf16_t*)(S + 192 * MiB), IN(30) + (size_t)j * 16 * 257); }
        else if (HAS(OP_XATT) && op == OP_XATT) { mem_attn_phase((const bf16_t*)S, WM, WM + 8 * MiB / 2, (bf16_t*)(S + 64 * MiB)); }
        else if (HAS(OP_MLP1) && op == OP_MLP1) {
            EpiT<5> E{{(bf16_t*)S, nullptr, FF, nullptr, nullptr, 1.f, 0}};
            run_gemm(lds, HB, WC + WC_W1 / 2, M, FF, D, 1 << 30, 0, E);
        }
    }
}

#ifndef MK_COOP
#define MK_COOP 0
#endif
template <unsigned MASK> static void launch_one(const Args& a, hipStream_t stream) {
    static bool attr = false;
    if (!attr) { attr = true; if (hipFuncSetAttribute((const void*)fwd<MASK>, hipFuncAttributeMaxDynamicSharedMemorySize, LDS_BYTES) != hipSuccess) fprintf(stderr, "kernel_launch: hipFuncSetAttribute failed\n"); }
    hipLaunchKernelGGL(fwd<MASK>, dim3(256), dim3(512), LDS_BYTES, stream, a);
}
extern "C" void kernel_launch(void* const* d_in, const int* in_sizes, int n_in, void* d_out, int out_size, void* d_ws, size_t ws_size, hipStream_t stream) {
    static int ready = 0;
    if (ready == 0) {
        ready = 1;
        if (n_in != 37 || out_size != M * D || ws_size < WS_END) { fprintf(stderr, "kernel_launch: unexpected shapes: n_in %d out %d ws %zu (need %zu)\n", n_in, out_size, ws_size, (size_t)WS_END); ready = -1; }
    }
    if (ready < 0) return;
    Args a{};
    for (int i = 0; i < 37; ++i) a.in[i] = (const float*)d_in[i];
    a.out = (float*)d_out; a.ws = (unsigned char*)d_ws;
#if MK_COOP
    static bool attr = false;
    if (!attr) { attr = true; if (hipFuncSetAttribute((const void*)fwd<0xFFFFFFFFu>, hipFuncAttributeMaxDynamicSharedMemorySize, LDS_BYTES) != hipSuccess) fprintf(stderr, "kernel_launch: hipFuncSetAttribute failed\n"); }
    a.lo = 0; a.hi = NPHASE;
    void* args[] = {&a};
    hipError_t e = hipLaunchCooperativeKernel((const void*)fwd<0xFFFFFFFFu>, dim3(256), dim3(512), args, LDS_BYTES, stream);
    if (e != hipSuccess) fprintf(stderr, "kernel_launch: cooperative launch failed: %s\n", hipGetErrorString(e));
#else
    for (int pc = 0; pc < NPHASE; ++pc) {
        a.lo = pc; a.hi = pc + 1;
        int L, s, kind, j, op, sub; decode_phase(pc, L, s, kind, j, op, sub);
        switch (op) {
            case OP_PRO: launch_one<1u << OP_PRO>(a, stream); break;
            case OP_WIN: launch_one<1u << OP_WIN>(a, stream); break;
            case OP_CONV: launch_one<1u << OP_CONV>(a, stream); break;
            case OP_GATES: launch_one<1u << OP_GATES>(a, stream); break;
            case OP_SCAN: launch_one<1u << OP_SCAN>(a, stream); break;
            case OP_RES: launch_one<1u << OP_RES>(a, stream); break;
            case OP_LN: launch_one<1u << OP_LN>(a, stream); break;
            case OP_PREP: launch_one<1u << OP_PREP>(a, stream); break;
            case OP_L1: launch_one<1u << OP_L1>(a, stream); break;
            case OP_PLAIN: launch_one<1u << OP_PLAIN>(a, stream); break;
            case OP_L2: launch_one<1u << OP_L2>(a, stream); break;
            case OP_REC: launch_one<1u << OP_REC>(a, stream); break;
            case OP_CATT: launch_one<1u << OP_CATT>(a, stream); break;
            case OP_XATT: launch_one<1u << OP_XATT>(a, stream); break;
            default: launch_one<1u << OP_MLP1>(a, stream); break;
        }
    }
#endif
}
```

```cpp
#include <hip/hip_runtime.h>
#include <hip/hip_cooperative_groups.h>
#include <cstdio>
#include <cstdint>
namespace cg = cooperative_groups;
__device__ __forceinline__ int tidx() { int t = (int)threadIdx.x; asm volatile("" : "+v"(t)); return t; }
__device__ __forceinline__ int bidx() { int t = (int)blockIdx.x; asm volatile("" : "+s"(t)); return t; }
__device__ __forceinline__ int gdim() { int t = (int)gridDim.x; asm volatile("" : "+s"(t)); return t; }
#define MK_COOP 1
namespace pg8 {
#define PG8_LAS __attribute__((address_space(3)))
typedef unsigned short bf16_t;
typedef short bf16x8 __attribute__((ext_vector_type(8)));
typedef float f32x4 __attribute__((ext_vector_type(4)));
typedef unsigned u32x4 __attribute__((ext_vector_type(4)));
constexpr int BM = 256, BK = 64, HALF = 128, HTB = HALF * BK * 2  , STAGE_BYTES = 8 * HTB, NXCD = 8, WGM = 8;

__host__ __device__ __forceinline__ int lds_byte(int r, int c) { const int st = (r >> 4) * 2 + (c >> 5), rr = r & 15, cc = c & 31, ob = rr * 64 + cc * 2; return st * 1024 + (ob ^ (((ob >> 9) & 1) << 5)); }
__host__ __device__ __forceinline__ void stage_rc(int b, int& R, int& C) { const int st = b / 1024, sb = b % 1024, swz = sb ^ (((sb >> 9) & 1) << 5); R = (st >> 1) * 16 + swz / 64; C = (st & 1) * 32 + (swz % 64) / 2; }
__host__ __device__ __forceinline__ int perm32(int rho) { const int n = rho >> 4, i = rho & 15; return 8 * (i >> 2) + 4 * n + (i & 3); }

struct Unit { int pm, pn; };
struct Gemm { const bf16_t* A; const bf16_t* Bt; int M, N, K; int asplit; size_t astride; };

struct StaticOrder {
    int nM, nN, nwg, G, c;
    __host__ __device__ void init(int M, int N, int G_, int c_) { nM = M / BM; nN = N / BM; nwg = nM * nN; G = G_; c = c_; }
    __host__ __device__ bool next(int i, Unit& u) const {
        const long L = (long)i * G + c; if (L >= nwg) return false;
        int wgid = (int)L; { const int q = nwg / NXCD, r = nwg % NXCD, xcd = wgid % NXCD, off = wgid / NXCD; wgid = (xcd < r ? xcd * (q + 1) : r * (q + 1) + (xcd - r) * q) + off; }
        const int nig = WGM * nN, gid = wgid / nig, fm = gid * WGM, gsz = (nM - fm) < WGM ? (nM - fm) : WGM;
        u.pm = fm + ((wgid % nig) % gsz); u.pn = (wgid % nig) / gsz; return true;
    }
    __device__ __forceinline__ void a_ready(const Unit&) const {}
    __device__ __forceinline__ void done(const Unit&) const {}
};

__device__ __forceinline__ unsigned cvt_pk_bf16(float lo, float hi) { unsigned r; asm volatile("v_cvt_pk_bf16_f32 %0, %1, %2" : "=v"(r) : "v"(lo), "v"(hi)); return r; }
typedef float f32x2 __attribute__((ext_vector_type(2)));
template <class Epi, class Sched, bool ALIGN_EPI = false, bool SP2 = false>
__device__ __forceinline__ void gemm_phase(PG8_LAS unsigned char* lds, const Gemm g, const Sched& S, const Epi& E) {
    const int tid = tidx(), wid = __builtin_amdgcn_readfirstlane(tid >> 6), lane = tid & 63, wr = wid >> 2, wc = wid & 3, fr = lane & 15, fq = lane >> 4;
    const int K = g.K, nt = K / BK;
    unsigned voffA[2], voffB[2];
#pragma unroll
    for (int i = 0; i < 2; ++i) { int R, C; stage_rc(tid * 16 + i * 8192, R, C); const int Rb = Epi::PERM ? ((R & ~31) + perm32(R & 31)) : R;
        voffA[i] = (unsigned)(R * K + C) * 2u; voffB[i] = (unsigned)(Rb * K + C) * 2u; }
    const size_t kstep = (size_t)(BK * 2);
    const size_t hstep = (size_t)HALF * K * 2;
    const size_t tstep = 2 * hstep;
    const unsigned ldsw = (unsigned)wid * 1024u;
    const int aoff = lds_byte(wr * 64 + fr, fq * 8), boff = lds_byte(wc * 32 + fr, fq * 8);
#define PG8_SA(b, h) (((b) * 2 + (h)) * HTB)
#define PG8_SB(b, h) ((4 + (b) * 2 + (h)) * HTB)
#define PG8_STAGE(bufoff, gbase, voff) do { _Pragma("unroll") for (int _i = 0; _i < 2; ++_i) \
        __builtin_amdgcn_global_load_lds((const unsigned*)((const char*)(gbase) + (voff)[_i]), (PG8_LAS unsigned*)(lds + (bufoff) + ldsw + _i * 8192), 16, 0, 0); } while (0)
#define PG8_LDA(dst, b, h) do { _Pragma("unroll") for (int m = 0; m < 4; ++m) _Pragma("unroll") for (int k = 0; k < 2; ++k) dst[m][k] = *(const PG8_LAS bf16x8*)(lds + PG8_SA(b, h) + aoff + m * 2048 + k * 1024); } while (0)
#define PG8_LDB(dst, b, h) do { _Pragma("unroll") for (int n = 0; n < 2; ++n) _Pragma("unroll") for (int k = 0; k < 2; ++k) dst[n][k] = *(const PG8_LAS bf16x8*)(lds + PG8_SB(b, h) + boff + n * 2048 + k * 1024); } while (0)
#define PG8_MMA(ai, bj, At, Bt) do { __builtin_amdgcn_s_setprio(1); _Pragma("unroll") for (int m = 0; m < 4; ++m) _Pragma("unroll") for (int n = 0; n < 2; ++n) _Pragma("unroll") for (int k = 0; k < 2; ++k) \
        acc[ai][bj][m][n] = __builtin_amdgcn_mfma_f32_16x16x32_bf16(Bt[n][k], At[m][k], acc[ai][bj][m][n], 0, 0, 0); __builtin_amdgcn_s_setprio(0); } while (0)
#define PG8_WAIT_V(n) asm volatile("s_waitcnt vmcnt(" #n ")" ::: "memory")
#define PG8_WAIT_L(n) asm volatile("s_waitcnt lgkmcnt(" #n ")" ::: "memory")
#define PG8_BAR __builtin_amdgcn_s_barrier()
#define PG8_SCHED __builtin_amdgcn_sched_barrier(0)
    Unit cur, nxt; int ui = 0;
    if (!S.next(0, cur)) return;
    f32x4 acc[2][2][4][2];
#pragma unroll
    for (int a = 0; a < 2; ++a)
#pragma unroll
        for (int b = 0; b < 2; ++b)
#pragma unroll
            for (int m = 0; m < 4; ++m)
#pragma unroll
                for (int n = 0; n < 2; ++n) acc[a][b][m][n] = (f32x4){0.f, 0.f, 0.f, 0.f};
    bf16x8 At[4][2], B0[2][2], B1[2][2];
    const char* cA = (const char*)g.A + (size_t)(cur.pn / g.asplit) * g.astride + (size_t)cur.pm * tstep; const char* cB = (const char*)g.Bt + (size_t)cur.pn * tstep;
    S.a_ready(cur);
    if constexpr (SP2) {
        PG8_STAGE(PG8_SB(0, 0), cB, voffB); PG8_STAGE(PG8_SB(0, 1), cB + hstep, voffB); PG8_STAGE(PG8_SA(0, 0), cA, voffA); PG8_STAGE(PG8_SA(0, 1), cA + hstep, voffA);
        if (wr == 1) PG8_BAR;
        PG8_WAIT_V(2); PG8_BAR;
        PG8_STAGE(PG8_SB(1, 0), cB + kstep, voffB); PG8_STAGE(PG8_SA(1, 0), cA + kstep, voffA); PG8_STAGE(PG8_SB(1, 1), cB + hstep + kstep, voffB);
        PG8_WAIT_V(6); PG8_BAR;
    } else {
        PG8_STAGE(PG8_SB(0, 0), cB, voffB); PG8_STAGE(PG8_SA(0, 0), cA, voffA); PG8_STAGE(PG8_SB(0, 1), cB + hstep, voffB); PG8_STAGE(PG8_SA(0, 1), cA + hstep, voffA);
        if (wr == 1) PG8_BAR;
        PG8_WAIT_V(4); PG8_BAR;
        PG8_STAGE(PG8_SB(1, 0), cB + kstep, voffB); PG8_STAGE(PG8_SA(1, 0), cA + kstep, voffA); PG8_STAGE(PG8_SB(1, 1), cB + hstep + kstep, voffB);
        PG8_WAIT_V(6); PG8_BAR;
    }
    for (;;) {
        const bool has_next = S.next(ui + 1, nxt);
        const char* nA = has_next ? (const char*)g.A + (size_t)(nxt.pn / g.asplit) * g.astride + (size_t)nxt.pm * tstep : cA; const char* nB = has_next ? (const char*)g.Bt + (size_t)nxt.pn * tstep : cB;
        for (int t = 0; t < nt; t += 2) {
            const bool last = (t == nt - 2);
            const char* a1 = cA + (size_t)(t + 1) * kstep;
            const char* a2 = last ? nA : cA + (size_t)(t + 2) * kstep; const char* b2 = last ? nB : cB + (size_t)(t + 2) * kstep;
            const char* a3 = a2 + kstep; const char* b3 = b2 + kstep;
            if (last && has_next) S.a_ready(nxt);
            if constexpr (SP2) {
            PG8_LDB(B0, 0, 0); PG8_LDB(B1, 0, 1); PG8_SCHED; PG8_LDA(At, 0, 0); PG8_STAGE(PG8_SA(1, 1), a1 + hstep, voffA);
            PG8_WAIT_V(8); PG8_WAIT_L(0); PG8_BAR; PG8_MMA(0, 0, At, B0); PG8_MMA(0, 1, At, B1); PG8_BAR; PG8_SCHED;
            PG8_LDA(At, 0, 1); PG8_STAGE(PG8_SB(0, 0), b2, voffB); PG8_STAGE(PG8_SB(0, 1), b2 + hstep, voffB); PG8_STAGE(PG8_SA(0, 0), a2, voffA);
            PG8_WAIT_V(8); PG8_WAIT_L(0); PG8_BAR; PG8_MMA(1, 0, At, B0); PG8_MMA(1, 1, At, B1); PG8_BAR; PG8_SCHED;
            PG8_LDB(B0, 1, 0); PG8_LDB(B1, 1, 1); PG8_SCHED; PG8_LDA(At, 1, 0); PG8_STAGE(PG8_SA(0, 1), a2 + hstep, voffA);
            PG8_WAIT_V(8); PG8_WAIT_L(0); PG8_BAR; PG8_MMA(0, 0, At, B0); PG8_MMA(0, 1, At, B1); PG8_BAR; PG8_SCHED;
            PG8_LDA(At, 1, 1); PG8_STAGE(PG8_SB(1, 0), b3, voffB); PG8_STAGE(PG8_SB(1, 1), b3 + hstep, voffB); PG8_STAGE(PG8_SA(1, 0), a3, voffA);
            PG8_WAIT_V(8); PG8_WAIT_L(0); PG8_BAR; PG8_MMA(1, 0, At, B0); PG8_MMA(1, 1, At, B1); PG8_BAR; PG8_SCHED;
            } else {
            PG8_LDB(B0, 0, 0); PG8_SCHED; PG8_LDA(At, 0, 0); PG8_STAGE(PG8_SA(1, 1), a1 + hstep, voffA);
            PG8_WAIT_L(8); PG8_BAR; PG8_WAIT_L(0); PG8_MMA(0, 0, At, B0); PG8_BAR; PG8_SCHED;
            PG8_LDB(B1, 0, 1); PG8_STAGE(PG8_SB(0, 0), b2, voffB);
            PG8_BAR; PG8_WAIT_L(0); PG8_MMA(0, 1, At, B1); PG8_BAR;
            PG8_LDA(At, 0, 1); PG8_STAGE(PG8_SA(0, 0), a2, voffA);
            PG8_BAR; PG8_WAIT_L(0); PG8_MMA(1, 0, At, B0); PG8_BAR; PG8_SCHED;
            PG8_STAGE(PG8_SB(0, 1), b2 + hstep, voffB);
            PG8_WAIT_V(6); PG8_BAR; PG8_MMA(1, 1, At, B1); PG8_BAR;
            PG8_LDB(B0, 1, 0); PG8_SCHED; PG8_LDA(At, 1, 0); PG8_STAGE(PG8_SA(0, 1), a2 + hstep, voffA);
            PG8_WAIT_L(8); PG8_BAR; PG8_WAIT_L(0); PG8_MMA(0, 0, At, B0); PG8_BAR; PG8_SCHED;
            PG8_LDB(B1, 1, 1); PG8_STAGE(PG8_SB(1, 0), b3, voffB);
            PG8_BAR; PG8_WAIT_L(0); PG8_MMA(0, 1, At, B1); PG8_BAR;
            PG8_LDA(At, 1, 1); PG8_STAGE(PG8_SA(1, 0), a3, voffA);
            PG8_BAR; PG8_WAIT_L(0); PG8_MMA(1, 0, At, B0); PG8_BAR; PG8_SCHED;
            PG8_STAGE(PG8_SB(1, 1), b3 + hstep, voffB);
            PG8_WAIT_V(6); PG8_BAR; PG8_MMA(1, 1, At, B1); PG8_BAR;
            }
        }
        if constexpr (ALIGN_EPI) { if (wr == 0) PG8_BAR; }
        if constexpr (!Epi::AFTER_DRAIN) { E(acc, cur, wr, wc, fr, fq); S.done(cur); }
        if (!has_next) break;
#pragma unroll
        for (int a = 0; a < 2; ++a)
#pragma unroll
            for (int b = 0; b < 2; ++b)
#pragma unroll
                for (int m = 0; m < 4; ++m)
#pragma unroll
                    for (int n = 0; n < 2; ++n) acc[a][b][m][n] = (f32x4){0.f, 0.f, 0.f, 0.f};
        cur = nxt; cA = nA; cB = nB; ++ui;
        if constexpr (ALIGN_EPI) { if (wr == 1) PG8_BAR; }
    }
    PG8_WAIT_V(0);
    if constexpr (!ALIGN_EPI) { if (wr == 0) PG8_BAR; }
    PG8_BAR;
    if constexpr (Epi::AFTER_DRAIN) { E.fused(acc, cur, wr, wc, fr, fq, lds, wid, lane); S.done(cur); }
#undef PG8_SA
#undef PG8_SB
#undef PG8_STAGE
#undef PG8_LDA
#undef PG8_LDB
#undef PG8_MMA
#undef PG8_WAIT_V
#undef PG8_WAIT_L
#undef PG8_BAR
#undef PG8_SCHED
}
}

using pg8::bf16_t; using pg8::f32x4; using pg8::bf16x8; using pg8::u32x4;
#define LAS __attribute__((address_space(3)))
typedef unsigned u32x2 __attribute__((ext_vector_type(2)));
typedef float f32x2 __attribute__((ext_vector_type(2)));

constexpr int M = 32768, D = 1024, SEQ = 2048, NB = 16, DR = 1344, DP = 1536, FF = 4096, MEMT = 256, MM = NB * MEMT;
constexpr float ALPHA = 1.6817928305074290f, LN_EPS = 1e-5f, LOG2E = 1.4426950408889634f;
constexpr size_t MiB = 1u << 20;
constexpr size_t WS_WC = 1 * MiB, WS_MEMB = 25 * MiB, WS_WM = 33 * MiB, WS_HB = 53 * MiB, WS_S = 117 * MiB, WS_END = 501 * MiB;
constexpr size_t WC_Q = 0, WC_K = 2 * MiB, WC_V = 4 * MiB, WC_O = 6 * MiB, WC_W1 = 8 * MiB, WC_W2 = 16 * MiB;
constexpr int LDS_BYTES = 147456;
constexpr int NPHASE = 53;

__device__ __forceinline__ unsigned f2bf(float f) { unsigned u = __builtin_bit_cast(unsigned, f); return (u + 0x7fffu + ((u >> 16) & 1u)) >> 16; }
__device__ __forceinline__ unsigned pk2(float lo, float hi) { return f2bf(lo) | (f2bf(hi) << 16); }
__device__ __forceinline__ float bflo(unsigned u) { return __uint_as_float(u << 16); }
__device__ __forceinline__ float bfhi(unsigned u) { return __uint_as_float(u & 0xffff0000u); }
__device__ __forceinline__ float sigmoid_(float x) { return 1.0f / (1.0f + __expf(-x)); }
__device__ __forceinline__ float softplus_(float x) { return fmaxf(x, 0.f) + __logf(1.0f + __expf(-fabsf(x))); }
__device__ __forceinline__ float tanh_(float x) { return 1.0f - 2.0f / (1.0f + __expf(2.0f * x)); }
__device__ __forceinline__ float gelu_tanh_(float x) { return 0.5f * x * (1.0f + tanh_(0.7978845608028654f * (x + 0.044715f * x * x * x))); }

struct EpiP { bf16_t* O; bf16_t* O2; int ldc; const float* p0; const float* p1; float scale; int scale_cols; };
template <int MODE> struct EpiT {
    static constexpr bool PERM = true, AFTER_DRAIN = false; EpiP P;
    __device__ __forceinline__ void operator()(const f32x4 (&acc)[2][2][4][2], const pg8::Unit& u, int wr, int wc, int fr, int fq) const {
        const int row0 = u.pm * 256 + wr * 64 + fr;
#pragma unroll
        for (int bj = 0; bj < 2; ++bj) {
            const int col = u.pn * 256 + bj * 128 + wc * 32 + 8 * fq;
            float bias[8];
#pragma unroll
            for (int e = 0; e < 8; ++e) bias[e] = 0.f;
            bf16_t* base = P.O; int ocol = col; float sc = 1.f;
            if (MODE == 0) { sc = (col < P.scale_cols) ? P.scale : 1.f; }
            if (MODE == 1) { if (col >= DP) { base = P.O2; ocol = col - DP; } }
            if (MODE == 2) { const int g = col / DP, cc = col - g * DP; if (cc < DR) {
#pragma unroll
                    for (int e = 0; e < 8; ++e) bias[e] = P.p0[g * DR + cc + e]; } }
            if (MODE == 4) { if (col < 2048) { const float* bp = (col < 1024) ? (P.p0 + col) : (P.p1 + (col - 1024));
#pragma unroll
                    for (int e = 0; e < 8; ++e) bias[e] = bp[e]; } }
#pragma unroll
            for (int ai = 0; ai < 2; ++ai)
#pragma unroll
                for (int m = 0; m < 4; ++m) {
                    const int row = row0 + ai * 128 + m * 16;
                    float v[8];
#pragma unroll
                    for (int e = 0; e < 4; ++e) { v[e] = acc[ai][bj][m][0][e]; v[4 + e] = acc[ai][bj][m][1][e]; }
#pragma unroll
                    for (int e = 0; e < 8; ++e) {
                        float x = v[e] + bias[e];
                        if (MODE == 0) x *= sc;
                        if (MODE == 1) { if (col < DP) x = gelu_tanh_(x); }
                        if (MODE == 2) x = sigmoid_(x);
                        if (MODE == 3) { if (col < 64) x = tanh_(x); else if (col >= 128) x = sigmoid_(x); }
                        if (MODE == 4) { if (col < 1024) { const float wl = -softplus_(-x) - 0.5f; x = -__expf(wl); } else if (col < 2048) x = sigmoid_(x); }
                        if (MODE == 5) { x = fmaxf(x, 0.f); x = x * x; }
                        v[e] = x;
                    }
                    u32x4 w; w.x = pg8::cvt_pk_bf16(v[0], v[1]); w.y = pg8::cvt_pk_bf16(v[2], v[3]); w.z = pg8::cvt_pk_bf16(v[4], v[5]); w.w = pg8::cvt_pk_bf16(v[6], v[7]);
                    *(u32x4*)(base + (size_t)row * P.ldc + ocol) = w;
                    asm volatile("" ::: "memory");
                }
        }
    }
};
struct EpiRes {
    static constexpr bool PERM = true, AFTER_DRAIN = false; float* out;
    __device__ __forceinline__ void operator()(const f32x4 (&acc)[2][2][4][2], const pg8::Unit& u, int wr, int wc, int fr, int fq) const {
        const int row0 = u.pm * 256 + wr * 64 + fr;
#pragma unroll
        for (int bj = 0; bj < 2; ++bj) {
            const int col = u.pn * 256 + bj * 128 + wc * 32 + 8 * fq;
#pragma unroll
            for (int ai = 0; ai < 2; ++ai)
#pragma unroll
                for (int m = 0; m < 4; ++m) {
                    float* p = out + (size_t)(row0 + ai * 128 + m * 16) * D + col;
                    f32x4 b0 = *(const f32x4*)p, b1 = *(const f32x4*)(p + 4);
                    b0 = b0 * ALPHA + acc[ai][bj][m][0]; b1 = b1 * ALPHA + acc[ai][bj][m][1];
                    *(f32x4*)p = b0; *(f32x4*)(p + 4) = b1;
                    if (m & 1) asm volatile("" ::: "memory");
                }
        }
    }
};

template <class Epi> __device__ __forceinline__ void run_gemm(LAS unsigned char* lds, const bf16_t* A, const bf16_t* Bt, int M_, int N_, int K_, int asplit, size_t astride, const Epi& E) {
    asm volatile("" : "+s"(K_));
    pg8::Gemm g{A, Bt, M_, N_, K_, asplit, astride}; pg8::StaticOrder S; S.init(M_, N_, gdim(), bidx());
    pg8::gemm_phase<Epi, pg8::StaticOrder, true, true>(lds, g, S, E);
}

__device__ __forceinline__ void tr_item(const float* W, int ldn, int c0, int N, bf16_t* WT, int ldw, int row_off, int koff, LAS float* scr, int item, int lane) {
    const int nblk = N / 32, kb = item / nblk, nb = item % nblk, k0 = 64 * kb, n0 = 32 * nb;
#pragma unroll 8
    for (int i = 0; i < 32; ++i) { const int kk = 2 * i + (lane >> 5); scr[kk * 33 + (lane & 31)] = W[(size_t)(k0 + kk) * ldn + c0 + n0 + (lane & 31)]; }
    asm volatile("s_waitcnt lgkmcnt(0)" ::: "memory");
    const int c = lane & 7;
#pragma unroll
    for (int j = 0; j < 4; ++j) { const int n = (lane >> 3) + 8 * j; const LAS float* s = scr + (8 * c) * 33 + n;
        u32x4 o; o.x = pk2(s[0 * 33], s[1 * 33]); o.y = pk2(s[2 * 33], s[3 * 33]); o.z = pk2(s[4 * 33], s[5 * 33]); o.w = pk2(s[6 * 33], s[7 * 33]);
        *(u32x4*)(WT + (size_t)(row_off + n0 + n) * ldw + koff + k0 + 8 * c) = o; }
    asm volatile("s_waitcnt lgkmcnt(0)" ::: "memory");
}
#define TRJOB(W, ldn, c0, K, N, WT, ldw, roff, koff) { const int cnt_ = ((K) / 64) * ((N) / 32); if (r < cnt_) { tr_item(W, ldn, c0, N, WT, ldw, roff, koff, scr, r, lane); continue; } r -= cnt_; }

struct Args { const float* in[37]; float* out; unsigned char* ws; int lo, hi; };
constexpr int TAB_OFF = 131072 + 1024;
__device__ __forceinline__ const float* ldp(LAS unsigned char* lds, int i) {
    volatile LAS unsigned* t = (volatile LAS unsigned*)(lds + TAB_OFF) + 2 * i;
    const unsigned lo = (unsigned)__builtin_amdgcn_readfirstlane((int)t[0]), hi = (unsigned)__builtin_amdgcn_readfirstlane((int)t[1]);
    return (const float*)(((unsigned long long)hi << 32) | (unsigned long long)lo);
}
#define IN(i) ldp(lds, (i))
#define WSP ((unsigned char*)ldp(lds, 38))
#define OUTP ((float*)ldp(lds, 37))

__device__ __forceinline__ void convert_layer(int L, LAS unsigned char* lds) {
    const int tid = tidx(), lane = tid & 63, wave = tid >> 6;
    const int gw = bidx() * 8 + wave, NGW = gdim() * 8;
    LAS float* scr = (LAS float*)(lds + wave * 16384);
    unsigned char* wsp_ = WSP; bf16_t* WC = (bf16_t*)(wsp_ + WS_WC); bf16_t* WM = (bf16_t*)(wsp_ + WS_WM);
    const int kind = L % 3, j = L / 3;
    const float* wq = IN(32) + (size_t)L * D * D; const float* wkv = IN(33) + (size_t)L * D * 2 * D; const float* wo = IN(34) + (size_t)L * D * D;
    const float* w1 = IN(35) + (size_t)L * D * FF; const float* w2 = IN(36) + (size_t)L * FF * D;
    for (int it = gw;; it += NGW) {
        int r = it;
        TRJOB(wq, D, 0, D, D, WC + WC_Q / 2, D, 0, 0)
        TRJOB(wkv, 2 * D, 0, D, D, WC + WC_K / 2, D, 0, 0)
        TRJOB(wkv, 2 * D, D, D, D, WC + WC_V / 2, D, 0, 0)
        TRJOB(wo, D, 0, D, D, WC + WC_O / 2, D, 0, 0)
        TRJOB(w1, FF, 0, D, FF, WC + WC_W1 / 2, D, 0, 0)
        TRJOB(w2, D, 0, FF, D, WC + WC_W2 / 2, FF, 0, 0)
        if (kind == 0) {
            const float* win = IN(4) + (size_t)j * D * 2 * DR; const float* wout = IN(10) + (size_t)j * DR * D;
            TRJOB(win, 2 * DR, 0, D, DR, WM, D, 0, 0)
            TRJOB(win, 2 * DR, DR, D, DR, WM, D, DP, 0)
            TRJOB(wout, D, 0, DR, D, WM + 15 * MiB / 2, DP, 0, 0)
        } else if (kind == 1) {
            const float* wr = IN(12) + (size_t)j * D * D; const float* wk = IN(13) + (size_t)j * D * D; const float* wv = IN(14) + (size_t)j * D * D; const float* wo2 = IN(28) + (size_t)j * D * D;
            TRJOB(wr, D, 0, D, D, WM, D, 0, 0)
            TRJOB(wk, D, 0, D, D, WM, D, D, 0)
            TRJOB(wv, D, 0, D, D, WM, D, 2 * D, 0)
            TRJOB(wo2, D, 0, D, D, WM + 10 * MiB / 2, D, 0, 0)
        } else {
            const float* wqkv = IN(29) + (size_t)j * D * 3 * D; const float* wo2 = IN(31) + (size_t)j * D * D;
            TRJOB(wqkv, 3 * D, 0, D, 2 * D, WM, D, 0, 0)
            TRJOB(wqkv, 3 * D, 2 * D, D, D, WM + 4 * MiB / 2, D, 0, 0)
            TRJOB(wo2, D, 0, D, D, WM + 6 * MiB / 2, D, 0, 0)
        }
        break;
    }
    const int gt = bidx() * 512 + tid, NGT = gdim() * 512;
    if (kind == 0) {
        const float* gwt = IN(7) + (size_t)j * 2 * 16 * 84 * 84;
        bf16_t* GW = WM + 6 * MiB / 2;
        for (int idx = gt; idx < 3072 * (DP / 8); idx += NGT) {
            const int n = idx / (DP / 8), k0 = (idx % (DP / 8)) * 8; const int g = n / DP, cc = n % DP; float v[8];
#pragma unroll
            for (int e = 0; e < 8; ++e) { const int k = k0 + e; v[e] = (cc < DR && k < DR && (cc / 84) == (k / 84)) ? gwt[(((size_t)g * 16 + cc / 84) * 84 + (k % 84)) * 84 + (cc % 84)] : 0.f; }
            u32x4 o; o.x = pk2(v[0], v[1]); o.y = pk2(v[2], v[3]); o.z = pk2(v[4], v[5]); o.w = pk2(v[6], v[7]);
            *(u32x4*)(GW + (size_t)n * DP + k0) = o;
        }
        for (int idx = gt; idx < 2 * 192 * (D / 8); idx += NGT) {
            const int rr = idx / (D / 8), k0 = (idx % (D / 8)) * 8; const int n = (rr < 192) ? (DR + rr) : (DP + DR + rr - 192);
            *(u32x4*)(WM + (size_t)n * D + k0) = (u32x4){0u, 0u, 0u, 0u};
        }
        bf16_t* WOUT = WM + 15 * MiB / 2;
        for (int idx = gt; idx < D * 24; idx += NGT) {
            const int n = idx / 24, k0 = DR + (idx % 24) * 8;
            *(u32x4*)(WOUT + (size_t)n * DP + k0) = (u32x4){0u, 0u, 0u, 0u};
        }
    } else if (kind == 1) {
        const float* w1_ = IN(16) + (size_t)j * D * 64; const float* a1_ = IN(19) + (size_t)j * D * 64; const float* g1_ = IN(21) + (size_t)j * D * 128;
        const float* w2_ = IN(17) + (size_t)j * 64 * D; const float* a2_ = IN(20) + (size_t)j * 64 * D; const float* g2_ = IN(22) + (size_t)j * 128 * D;
        bf16_t* WL1 = WM + 6 * MiB / 2; bf16_t* WL2 = WM + 8 * MiB / 2;
        for (int idx = gt; idx < 256 * (3072 / 8); idx += NGT) {
            const int n = idx / 384, k0 = (idx % 384) * 8; float v[8];
#pragma unroll
            for (int e = 0; e < 8; ++e) { const int k = k0 + e; float x = 0.f;
                if (n < 64) { if (k < 1024) x = w1_[(size_t)k * 64 + n]; }
                else if (n < 128) { if (k >= 1024 && k < 2048) x = a1_[(size_t)(k - 1024) * 64 + (n - 64)]; }
                else { if (k >= 2048) x = g1_[(size_t)(k - 2048) * 128 + (n - 128)]; }
                v[e] = x; }
            u32x4 o; o.x = pk2(v[0], v[1]); o.y = pk2(v[2], v[3]); o.z = pk2(v[4], v[5]); o.w = pk2(v[6], v[7]);
            *(u32x4*)(WL1 + (size_t)n * 3072 + k0) = o;
        }
        for (int idx = gt; idx < 3072 * 32; idx += NGT) {
            const int n = idx / 32, k0 = (idx % 32) * 8; float v[8];
#pragma unroll
            for (int e = 0; e < 8; ++e) { const int k = k0 + e; float x = 0.f;
                if (n < 1024) { if (k < 64) x = w2_[(size_t)k * D + n]; }
                else if (n < 2048) { if (k >= 64 && k < 128) x = a2_[(size_t)(k - 64) * D + (n - 1024)]; }
                else { if (k >= 128) x = g2_[(size_t)(k - 128) * D + (n - 2048)]; }
                v[e] = x; }
            u32x4 o; o.x = pk2(v[0], v[1]); o.y = pk2(v[2], v[3]); o.z = pk2(v[4], v[5]); o.w = pk2(v[6], v[7]);
            *(u32x4*)(WL2 + (size_t)n * 256 + k0) = o;
        }
    }
}

__device__ __forceinline__ void ln_phase(float* H, bf16_t* HB, const float* g, const float* b) {
    const int tid = tidx(), lane = tid & 63, wave = tid >> 6;
    const int gw = bidx() * 8 + wave, NGW = gdim() * 8;
    f32x4 gv[4], bv[4];
#pragma unroll
    for (int j = 0; j < 4; ++j) { gv[j] = *(const f32x4*)(g + 256 * j + 4 * lane); bv[j] = *(const f32x4*)(b + 256 * j + 4 * lane); }
    for (int m = gw; m < M; m += NGW) {
        float* row = H + (size_t)m * D + 4 * lane; f32x4 v[4]; float s = 0.f;
#pragma unroll
        for (int j = 0; j < 4; ++j) { v[j] = *(const f32x4*)(row + 256 * j); s += (v[j].x + v[j].y) + (v[j].z + v[j].w); }
#pragma unroll
        for (int o = 1; o < 64; o <<= 1) s += __shfl_xor(s, o);
        const float mean = s * (1.f / D); float s2 = 0.f;
#pragma unroll
        for (int j = 0; j < 4; ++j) { v[j] = v[j] - mean; s2 += (v[j].x * v[j].x + v[j].y * v[j].y) + (v[j].z * v[j].z + v[j].w * v[j].w); }
#pragma unroll
        for (int o = 1; o < 64; o <<= 1) s2 += __shfl_xor(s2, o);
        const float rstd = 1.f / sqrtf(s2 * (1.f / D) + LN_EPS);
        bf16_t* hb = HB + (size_t)m * D + 4 * lane;
#pragma unroll
        for (int j = 0; j < 4; ++j) { const f32x4 y = v[j] * rstd * gv[j] + bv[j]; *(f32x4*)(row + 256 * j) = y;
            u32x2 w; w.x = pk2(y.x, y.y); w.y = pk2(y.z, y.w); *(u32x2*)(hb + 256 * j) = w; }
    }
}
#define XB_TMO      128
#define XB_XCNT(j)  (256  + 64 * (j))
#define XB_XSUB(j)  (1280 + 64 * (j))
#define XB_XGEN(j)  (2304 + 64 * (j))
#define XB_TOP      3328
#define XB_TOPGEN   3392
#define XCD_BAR_WORDS 3456
#define XB_SPIN_CAP (1u << 18)

__device__ __forceinline__ unsigned xb_ld(unsigned* p)              { return __hip_atomic_load(p, __ATOMIC_RELAXED, __HIP_MEMORY_SCOPE_AGENT); }
__device__ __forceinline__ unsigned xb_add(unsigned* p, unsigned v) { return __hip_atomic_fetch_add(p, v, __ATOMIC_RELAXED, __HIP_MEMORY_SCOPE_AGENT); }
__device__ __forceinline__ unsigned xb_xcc_id() { return (unsigned)__builtin_amdgcn_s_getreg((3 << 11) | 20) & 0xFu; }
#define XB_SPIN(cond, bar) do { unsigned _sp = 0; while (cond) { __builtin_amdgcn_s_sleep(1); \
    if ((++_sp & 255u) == 0u) { if (xb_ld(&(bar)[XB_TMO])) break; if (_sp > XB_SPIN_CAP) { atomicAdd(&(bar)[XB_TMO], 1u); break; } } } } while (0)

struct XcdBarrier {
    unsigned* bar; unsigned x;
    volatile LAS unsigned* st;
};

__device__ __forceinline__ XcdBarrier xcd_barrier_post(unsigned* bar, volatile LAS unsigned* st) {
    XcdBarrier b; b.bar = bar; b.x = xb_xcc_id(); b.st = st;
    if (tidx() == 0) (void)xb_add(&bar[XB_XCNT(b.x)], 1u);
    return b;
}
__device__ __forceinline__ void xcd_barrier_complete(unsigned* bar, unsigned x, unsigned& nloc, unsigned& nx) {
    const unsigned G = gridDim.x * gridDim.y * gridDim.z;
    unsigned sum, cnt, mine, sp = 0u;
    for (;;) {
        sum = 0u; cnt = 0u; mine = 0u;
#pragma unroll
        for (unsigned j = 0; j < 16; ++j) { const unsigned c = xb_ld(&bar[XB_XCNT(j)]); sum += c; cnt += (c > 0u) ? 1u : 0u; mine = (j == x) ? c : mine; }
        if (sum == G) break;
        __builtin_amdgcn_s_sleep(1);
        if ((++sp & 255u) == 0u) { if (xb_ld(&bar[XB_TMO])) break; if (sp > XB_SPIN_CAP) { atomicAdd(&bar[XB_TMO], 1u); break; } }
    }
    nloc = mine > 0u ? mine : 1u; nx = cnt > 0u ? cnt : 1u;
}

__device__ __forceinline__ void xcd_barrier(const XcdBarrier& b) {
    asm volatile("s_waitcnt vmcnt(0)" ::: "memory");
    __syncthreads();
    if (tidx() == 0) {
        unsigned* bar = b.bar;
        __builtin_amdgcn_s_waitcnt(0);
        unsigned nloc = b.st[0], nx = b.st[1];
        if (nloc == 0u) { xcd_barrier_complete(bar, b.x, nloc, nx); b.st[0] = nloc; b.st[1] = nx; }
        const unsigned old = xb_add(&bar[XB_XSUB(b.x)], 1u);
        const unsigned gen = old / nloc;
        if (old + 1u == (gen + 1u) * nloc) {
            __builtin_amdgcn_fence(__ATOMIC_RELEASE, "agent");
            asm volatile("s_waitcnt vmcnt(0)" ::: "memory");
            const unsigned og = xb_add(&bar[XB_TOP], 1u);
            const unsigned tg = og / nx;
            if (og + 1u == (tg + 1u) * nx) xb_add(&bar[XB_TOPGEN], 1u);
            else XB_SPIN(xb_ld(&bar[XB_TOPGEN]) == tg, bar);
            __builtin_amdgcn_fence(__ATOMIC_ACQUIRE, "agent");
            xb_add(&bar[XB_XGEN(b.x)], 1u);
            asm volatile("s_waitcnt vmcnt(0)" ::: "memory");
        } else {
            XB_SPIN(xb_ld(&bar[XB_XGEN(b.x)]) == gen, bar);
            __builtin_amdgcn_fence(__ATOMIC_ACQUIRE, "agent");
            asm volatile("s_waitcnt vmcnt(0)" ::: "memory");
        }
    }
    __syncthreads();
}

template <int HD, int NQT, bool BIAS>
__device__ __forceinline__ void attn_task(const bf16_t* Q, int ldq, const bf16_t* K, int ldk, const bf16_t* Vt, size_t ldv, int nkeys, bf16_t* O, int ldo,
                                          const float* relb, int qpos0, int kpos0, int lane) {
    const int l16 = lane & 15, fq = lane >> 4;
    bf16x8 qf[NQT][HD / 32];
#pragma unroll
    for (int t = 0; t < NQT; ++t)
#pragma unroll
        for (int ds = 0; ds < HD / 32; ++ds) qf[t][ds] = *(const bf16x8*)(Q + (size_t)(16 * t + l16) * ldq + 32 * ds + 8 * fq);
    f32x4 o[NQT][HD / 16]; float mrun[NQT], lsum[NQT];
#pragma unroll
    for (int t = 0; t < NQT; ++t) { mrun[t] = -INFINITY; lsum[t] = 0.f;
#pragma unroll
        for (int dt = 0; dt < HD / 16; ++dt) o[t][dt] = (f32x4){0.f, 0.f, 0.f, 0.f}; }
    float bfar = 0.f; if (BIAS) bfar = relb[256] * LOG2E;
    for (int key0 = 0; key0 < nkeys; key0 += 32) {
        f32x4 s[NQT][2];
#pragma unroll
        for (int t = 0; t < NQT; ++t) { s[t][0] = (f32x4){0.f, 0.f, 0.f, 0.f}; s[t][1] = (f32x4){0.f, 0.f, 0.f, 0.f}; }
        const bf16_t* kp = K + (size_t)(key0 + l16) * ldk + 8 * fq;
#pragma unroll
        for (int ds = 0; ds < HD / 32; ++ds) {
            const bf16x8 k0f = *(const bf16x8*)(kp + 32 * ds), k1f = *(const bf16x8*)(kp + (size_t)16 * ldk + 32 * ds);
#pragma unroll
            for (int t = 0; t < NQT; ++t) { s[t][0] = __builtin_amdgcn_mfma_f32_16x16x32_bf16(k0f, qf[t][ds], s[t][0], 0, 0, 0); s[t][1] = __builtin_amdgcn_mfma_f32_16x16x32_bf16(k1f, qf[t][ds], s[t][1], 0, 0, 0); }
        }
        bf16x8 pf[NQT];
        const bool farstep = BIAS && (qpos0 - (kpos0 + key0 + 31) >= 128);
#pragma unroll
        for (int t = 0; t < NQT; ++t) {
            float x[8];
#pragma unroll
            for (int kb = 0; kb < 2; ++kb)
#pragma unroll
                for (int e = 0; e < 4; ++e) {
                    float bb = 0.f;
                    if (BIAS) { if (farstep) bb = bfar; else { int rel = (qpos0 + 16 * t + l16) - (kpos0 + key0 + 16 * kb + 4 * fq + e); rel = rel < -128 ? -128 : (rel > 128 ? 128 : rel); bb = relb[rel + 128] * LOG2E; } }
                    x[4 * kb + e] = s[t][kb][e] * LOG2E + bb;
                }
            float mt = fmaxf(fmaxf(fmaxf(x[0], x[1]), fmaxf(x[2], x[3])), fmaxf(fmaxf(x[4], x[5]), fmaxf(x[6], x[7])));
            mt = fmaxf(mt, __shfl_xor(mt, 16)); mt = fmaxf(mt, __shfl_xor(mt, 32));
            const float mnew = fmaxf(mrun[t], mt), scl = __builtin_amdgcn_exp2f(mrun[t] - mnew); mrun[t] = mnew;
            float ps = 0.f;
#pragma unroll
            for (int e = 0; e < 8; ++e) { x[e] = __builtin_amdgcn_exp2f(x[e] - mnew); ps += x[e]; }
            lsum[t] = lsum[t] * scl + ps;
#pragma unroll
            for (int dt = 0; dt < HD / 16; ++dt) o[t][dt] = o[t][dt] * scl;
            u32x4 w; w.x = pg8::cvt_pk_bf16(x[0], x[1]); w.y = pg8::cvt_pk_bf16(x[2], x[3]); w.z = pg8::cvt_pk_bf16(x[4], x[5]); w.w = pg8::cvt_pk_bf16(x[6], x[7]);
            pf[t] = __builtin_bit_cast(bf16x8, w);
        }
        const bf16_t* vp = Vt + (size_t)l16 * ldv + key0 + 4 * fq;
#pragma unroll
        for (int dt = 0; dt < HD / 16; ++dt) {
            const u32x2 lo = *(const u32x2*)(vp + (size_t)(16 * dt) * ldv), hi = *(const u32x2*)(vp + (size_t)(16 * dt) * ldv + 16);
            const u32x4 vv = (u32x4){lo.x, lo.y, hi.x, hi.y}; const bf16x8 vf = __builtin_bit_cast(bf16x8, vv);
#pragma unroll
            for (int t = 0; t < NQT; ++t) o[t][dt] = __builtin_amdgcn_mfma_f32_16x16x32_bf16(vf, pf[t], o[t][dt], 0, 0, 0);
        }
    }
#pragma unroll
    for (int t = 0; t < NQT; ++t) {
        float l = lsum[t]; l += __shfl_xor(l, 16); l += __shfl_xor(l, 32); const float inv = 1.0f / l;
        bf16_t* op = O + (size_t)(16 * t + l16) * ldo + 4 * fq;
#pragma unroll
        for (int dt = 0; dt < HD / 16; ++dt) { const f32x4 v = o[t][dt] * inv; u32x2 w; w.x = pg8::cvt_pk_bf16(v[0], v[1]); w.y = pg8::cvt_pk_bf16(v[2], v[3]); *(u32x2*)(op + 16 * dt) = w; }
    }
}
__device__ __forceinline__ void chunk_attn_phase(const bf16_t* QK, const bf16_t* Vt, bf16_t* O, const float* relb) {
    const int tid = tidx(), lane = tid & 63, wave = tid >> 6;
    for (int task = bidx() * 8 + wave; task < 16384; task += gdim() * 8) {
        const int half = task & 1, c = (task >> 1) & 31, h = (task >> 6) & 15, b = task >> 10;
        const int kc0 = c > 8 ? c - 8 : 0;
        const size_t qrow = (size_t)b * SEQ + c * 64 + half * 32, krow = (size_t)b * SEQ + kc0 * 64;
        attn_task<64, 2, true>(QK + qrow * 2048 + h * 64, 2048, QK + krow * 2048 + 1024 + h * 64, 2048, Vt + (size_t)(h * 64) * M + krow, (size_t)M, (c + 1 - kc0) * 64,
                               O + qrow * D + h * 64, D, relb + h * 257, c * 64 + half * 32, kc0 * 64, lane);
    }
}
__device__ __forceinline__ void mem_attn_phase(const bf16_t* Qx, const bf16_t* Km, const bf16_t* Vtm, bf16_t* O) {
    const int tid = tidx(), lane = tid & 63, wave = tid >> 6;
    for (int task = bidx() * 8 + wave; task < 8192; task += gdim() * 8) {
        const int qt = task & 127, mh = (task >> 7) & 3, b = task >> 9;
        const size_t qrow = (size_t)b * SEQ + qt * 16;
        attn_task<256, 1, false>(Qx + qrow * D + mh * 256, D, Km + (size_t)(b * MEMT) * D + mh * 256, D, Vtm + (size_t)(mh * 256) * MM + b * MEMT, (size_t)MM, MEMT,
                                 O + qrow * D + mh * 256, D, nullptr, 0, 0, lane);
    }
}

__device__ __forceinline__ void conv_phase(const bf16_t* UX, bf16_t* XR, const float* cw, const float* cb) {
    const int gt = bidx() * 512 + tidx(), NGT = gdim() * 512;
    for (int idx = gt; idx < M * (DP / 8); idx += NGT) {
        const int m = idx / (DP / 8), c8 = (idx % (DP / 8)) * 8; u32x4 o = (u32x4){0u, 0u, 0u, 0u};
        if (c8 < DR) {
            const int t = m & (SEQ - 1); float acc[8];
#pragma unroll
            for (int e = 0; e < 8; ++e) acc[e] = cb[c8 + e];
#pragma unroll
            for (int k = 0; k < 4; ++k) { if (t - 3 + k >= 0) { const u32x4 u = *(const u32x4*)(UX + (size_t)(m - 3 + k) * DP + c8); const float* w = cw + k * DR + c8;
                    acc[0] += w[0] * bflo(u.x); acc[1] += w[1] * bfhi(u.x); acc[2] += w[2] * bflo(u.y); acc[3] += w[3] * bfhi(u.y);
                    acc[4] += w[4] * bflo(u.z); acc[5] += w[5] * bfhi(u.z); acc[6] += w[6] * bflo(u.w); acc[7] += w[7] * bfhi(u.w); } }
            o.x = pk2(acc[0], acc[1]); o.y = pk2(acc[2], acc[3]); o.z = pk2(acc[4], acc[5]); o.w = pk2(acc[6], acc[7]);
        }
        *(u32x4*)(XR + (size_t)m * DP + c8) = o;
    }
}
__device__ __forceinline__ void scan_phase(LAS unsigned char* lds, const bf16_t* GATES, const bf16_t* XR, bf16_t* UG, const float* lam) {
    const int tid = tidx(), ch = tid & 63, seg = tid >> 6;
    LAS float* sA = (LAS float*)lds; LAS float* sB = sA + 512;
    for (int unit = bidx(); unit < NB * 21; unit += gdim()) {
        const int b = unit / 21, c = (unit % 21) * 64 + ch;
        const float sp = 8.0f * softplus_(-lam[c]);
        const size_t m0 = (size_t)b * SEQ + seg * 256;
        float A = 1.f, B = 0.f;
#pragma unroll 4
        for (int t = 0; t < 256; ++t) {
            const size_t m = m0 + t;
            const float r = bflo(GATES[m * 3072 + c]), ig = bflo(GATES[m * 3072 + DP + c]), x = bflo(XR[m * DP + c]);
            const float la = -sp * r, av = __expf(la), bt = sqrtf(-expm1f(2.0f * la)) * (ig * x);
            B = av * B + bt; A *= av;
        }
        sA[seg * 64 + ch] = A; sB[seg * 64 + ch] = B;
        __syncthreads();
        float hh = 0.f;
        for (int s = 0; s < seg; ++s) hh = sA[s * 64 + ch] * hh + sB[s * 64 + ch];
#pragma unroll 4
        for (int t = 0; t < 256; ++t) {
            const size_t m = m0 + t;
            const float r = bflo(GATES[m * 3072 + c]), ig = bflo(GATES[m * 3072 + DP + c]), x = bflo(XR[m * DP + c]), ug = bflo(UG[m * DP + c]);
            const float la = -sp * r, av = __expf(la), bt = sqrtf(-expm1f(2.0f * la)) * (ig * x);
            hh = av * hh + bt;
            UG[m * DP + c] = (bf16_t)f2bf(hh * ug);
        }
        __syncthreads();
    }
}

__device__ __forceinline__ void prep_phase(const float* H, bf16_t* X, const float* mu, int mode) {
    const int gt = bidx() * 512 + tidx(), NGT = gdim() * 512;
    const int i0 = mode ? 0 : 1, i1 = mode ? 2 : 4, i2 = mode ? 3 : 5;
    for (int idx = gt; idx < M * (D / 8); idx += NGT) {
        const int m = idx >> 7, c8 = (idx & 127) * 8; const int t = m & (SEQ - 1);
        const float* hp = H + (size_t)m * D + c8;
        const f32x4 h0 = *(const f32x4*)hp, h1 = *(const f32x4*)(hp + 4);
        f32x4 p0 = (f32x4){0.f, 0.f, 0.f, 0.f}, p1 = p0;
        if (t > 0) { p0 = *(const f32x4*)(hp - D); p1 = *(const f32x4*)(hp - D + 4); }
        const f32x4 x0 = p0 - h0, x1 = p1 - h1;
#pragma unroll
        for (int q = 0; q < 3; ++q) {
            const int mi = q == 0 ? i0 : (q == 1 ? i1 : i2);
            const f32x4 m0 = *(const f32x4*)(mu + mi * D + c8), m1 = *(const f32x4*)(mu + mi * D + c8 + 4);
            const f32x4 y0 = h0 + x0 * m0, y1 = h1 + x1 * m1;
            u32x4 o; o.x = pk2(y0.x, y0.y); o.y = pk2(y0.z, y0.w); o.z = pk2(y1.x, y1.y); o.w = pk2(y1.z, y1.w);
            bf16_t* dst = mode ? (X + (size_t)q * M * D + (size_t)m * D + c8) : (X + (size_t)m * 3072 + q * D + c8);
            *(u32x4*)dst = o;
        }
    }
}
__device__ __forceinline__ void rwkv_rec_phase(LAS unsigned char* lds, const bf16_t* RKV, const bf16_t* DAG, bf16_t* YG, const float* k_k, const float* k_a, const float* r_k,
                                               const float* lnx_g, const float* lnx_b) {
    LAS float* sAA = (LAS float*)lds; LAS float* sBB = sAA + 1024; LAS float* sW = sAA + 2048; LAS float* sK = sAA + 3072; LAS float* sR = sAA + 4096; LAS float* sV = sAA + 5120; LAS float* sY = sAA + 6144;
    const int tid = tidx(), tt = tid >> 5, jp = tid & 31, ri = tid >> 3, cg8 = tid & 7;
    for (int unit = bidx(); unit < 256; unit += gdim()) {
        const int b = unit >> 4, h = unit & 15, hc = h * 64 + 2 * jp;
        const float kk0 = k_k[hc], kk1 = k_k[hc + 1], ka0 = k_a[hc], ka1 = k_a[hc + 1], rk0 = r_k[hc], rk1 = r_k[hc + 1];
        const float lg0 = lnx_g[hc], lg1 = lnx_g[hc + 1], lb0 = lnx_b[hc], lb1 = lnx_b[hc + 1];
        float st[8];
#pragma unroll
        for (int e = 0; e < 8; ++e) st[e] = 0.f;
        const size_t mbase = (size_t)b * SEQ;
        unsigned pr, pk, pv, pd, pa, pg;
        { const size_t m = mbase + tt; const bf16_t* p = RKV + m * 3072 + hc; const bf16_t* q = DAG + m * 3072 + hc;
          pr = *(const unsigned*)p; pk = *(const unsigned*)(p + 1024); pv = *(const unsigned*)(p + 2048); pd = *(const unsigned*)q; pa = *(const unsigned*)(q + 1024); pg = *(const unsigned*)(q + 2048); }
        for (int blk = 0; blk < SEQ / 16; ++blk) {
            const size_t m = mbase + blk * 16 + tt;
            const float r0 = bflo(pr), r1 = bfhi(pr), k0 = bflo(pk), k1 = bfhi(pk), v0 = bflo(pv), v1 = bfhi(pv);
            const float d0 = bflo(pd), d1 = bfhi(pd), a0 = bflo(pa), a1 = bfhi(pa), g0 = bflo(pg), g1 = bfhi(pg);
            const float q0 = k0 * kk0, q1 = k1 * kk1; float ss = q0 * q0 + q1 * q1;
#pragma unroll
            for (int o = 1; o < 32; o <<= 1) ss += __shfl_xor(ss, o);
            const float inv = 1.0f / fmaxf(sqrtf(ss), 1e-12f);
            const float n0 = q0 * inv, n1 = q1 * inv;
            const float kp0 = k0 * (1.0f + (a0 - 1.0f) * ka0), kp1 = k1 * (1.0f + (a1 - 1.0f) * ka1);
            float bon = r0 * kp0 * rk0 + r1 * kp1 * rk1;
#pragma unroll
            for (int o = 1; o < 32; o <<= 1) bon += __shfl_xor(bon, o);
            const int li = tt * 64 + 2 * jp;
            *(LAS f32x2*)(sAA + li) = (f32x2){-n0, -n1}; *(LAS f32x2*)(sBB + li) = (f32x2){n0 * a0, n1 * a1};
            *(LAS f32x2*)(sW + li) = (f32x2){__expf(d0), __expf(d1)}; *(LAS f32x2*)(sK + li) = (f32x2){kp0, kp1};
            *(LAS f32x2*)(sR + li) = (f32x2){r0, r1}; *(LAS f32x2*)(sV + li) = (f32x2){v0, v1};
            __syncthreads();
            if (blk + 1 < SEQ / 16) { const size_t m2 = m + 16; const bf16_t* p = RKV + m2 * 3072 + hc; const bf16_t* q = DAG + m2 * 3072 + hc;
                pr = *(const unsigned*)p; pk = *(const unsigned*)(p + 1024); pv = *(const unsigned*)(p + 2048); pd = *(const unsigned*)q; pa = *(const unsigned*)(q + 1024); pg = *(const unsigned*)(q + 2048); }
#pragma unroll 2
            for (int t2 = 0; t2 < 16; ++t2) {
                const int lo = t2 * 64 + 8 * cg8;
                const f32x4 aa0 = *(const LAS f32x4*)(sAA + lo), aa1 = *(const LAS f32x4*)(sAA + lo + 4), ww0 = *(const LAS f32x4*)(sW + lo), ww1 = *(const LAS f32x4*)(sW + lo + 4);
                const f32x4 bb0 = *(const LAS f32x4*)(sBB + lo), bb1 = *(const LAS f32x4*)(sBB + lo + 4), kx0 = *(const LAS f32x4*)(sK + lo), kx1 = *(const LAS f32x4*)(sK + lo + 4);
                const f32x4 rr0 = *(const LAS f32x4*)(sR + lo), rr1 = *(const LAS f32x4*)(sR + lo + 4); const float vi = sV[t2 * 64 + ri];
                float sa = (st[0] * aa0.x + st[1] * aa0.y) + (st[2] * aa0.z + st[3] * aa0.w) + (st[4] * aa1.x + st[5] * aa1.y) + (st[6] * aa1.z + st[7] * aa1.w);
                sa += __shfl_xor(sa, 1); sa += __shfl_xor(sa, 2); sa += __shfl_xor(sa, 4);
                st[0] = st[0] * ww0.x + sa * bb0.x + vi * kx0.x; st[1] = st[1] * ww0.y + sa * bb0.y + vi * kx0.y; st[2] = st[2] * ww0.z + sa * bb0.z + vi * kx0.z; st[3] = st[3] * ww0.w + sa * bb0.w + vi * kx0.w;
                st[4] = st[4] * ww1.x + sa * bb1.x + vi * kx1.x; st[5] = st[5] * ww1.y + sa * bb1.y + vi * kx1.y; st[6] = st[6] * ww1.z + sa * bb1.z + vi * kx1.z; st[7] = st[7] * ww1.w + sa * bb1.w + vi * kx1.w;
                float y = (st[0] * rr0.x + st[1] * rr0.y) + (st[2] * rr0.z + st[3] * rr0.w) + (st[4] * rr1.x + st[5] * rr1.y) + (st[6] * rr1.z + st[7] * rr1.w);
                y += __shfl_xor(y, 1); y += __shfl_xor(y, 2); y += __shfl_xor(y, 4);
                if (cg8 == 0) sY[t2 * 64 + ri] = y;
            }
            __syncthreads();
            const f32x2 yy = *(const LAS f32x2*)(sY + li);
            float sm = yy.x + yy.y;
#pragma unroll
            for (int o = 1; o < 32; o <<= 1) sm += __shfl_xor(sm, o);
            const float mean = sm * (1.0f / 64.0f), e0 = yy.x - mean, e1 = yy.y - mean; float vs = e0 * e0 + e1 * e1;
#pragma unroll
            for (int o = 1; o < 32; o <<= 1) vs += __shfl_xor(vs, o);
            const float rs = 1.0f / sqrtf(vs * (1.0f / 64.0f) + 64e-5f);
            const float o0 = ((e0 * rs) * lg0 + lb0 + bon * v0) * g0, o1 = ((e1 * rs) * lg1 + lb1 + bon * v1) * g1;
            *(unsigned*)(YG + m * D + hc) = pk2(o0, o1);
        }
        __syncthreads();
    }
}

#define HAS(x) ((OPMASK >> (x)) & 1u)
enum { OP_PRO, OP_WIN, OP_CONV, OP_GATES, OP_SCAN, OP_RES, OP_LN, OP_PREP, OP_L1, OP_PLAIN, OP_L2, OP_REC, OP_CATT, OP_XATT, OP_MLP1 };

__host__ __device__ __forceinline__ void decode_phase(int pc, int& L, int& s, int& kind, int& j, int& op, int& sub) {
    if (pc < 1) { L = 0; s = -1; } else if (pc < 14) { L = 0; s = pc - 1; } else if (pc < 29) { L = 1; s = pc - 14; } else if (pc < 40) { L = 2; s = pc - 29; } else { L = 3; s = pc - 40; }
    kind = L % 3; j = L / 3; const int mlen = kind == 0 ? 6 : (kind == 1 ? 8 : 4);
    sub = 0;
    if (s < 0) op = OP_PRO;
    else if (s < mlen) {
        if (kind == 0) { op = s == 0 ? OP_WIN : s == 1 ? OP_CONV : s == 2 ? OP_GATES : s == 3 ? OP_SCAN : s == 4 ? OP_RES : OP_LN; }
        else if (kind == 1) { op = s == 0 ? OP_PREP : s == 1 ? OP_L1 : s == 2 ? OP_PREP : s == 3 ? OP_PLAIN : s == 4 ? OP_L2 : s == 5 ? OP_REC : s == 6 ? OP_RES : OP_LN; sub = (s == 2) ? 1 : 0; }
        else { op = s == 0 ? OP_PLAIN : s == 1 ? OP_CATT : s == 2 ? OP_RES : OP_LN; sub = (s == 0) ? 1 : 0; }
    } else {
        const int cs = s - mlen;
        op = cs == 0 ? OP_PLAIN : cs == 1 ? OP_XATT : cs == 2 ? OP_RES : cs == 3 ? OP_LN : cs == 4 ? OP_MLP1 : cs == 5 ? OP_RES : OP_LN;
        sub = cs == 0 ? 2 : cs == 2 ? 1 : cs == 3 ? 1 : cs == 5 ? 2 : cs == 6 ? 2 : 0;
    }
}
template <unsigned OPMASK> __global__ void __launch_bounds__(512, 2) fwd(Args a0) {
    extern __shared__ __attribute__((aligned(16))) unsigned char lds_raw[];
    LAS unsigned char* lds = (LAS unsigned char*)lds_raw;
    cg::grid_group grid = cg::this_grid();
    const int plo = a0.lo, phi = a0.hi;
    if (tidx() == 0) {
        LAS unsigned long long* tab = (LAS unsigned long long*)(lds + TAB_OFF);
#pragma unroll
        for (int i = 0; i < 37; ++i) tab[i] = (unsigned long long)a0.in[i];
        tab[37] = (unsigned long long)a0.out; tab[38] = (unsigned long long)a0.ws;
    }
    volatile LAS unsigned* bst = (volatile LAS unsigned*)(lds + TAB_OFF + 512);
    if (tidx() == 0) { bst[0] = 0u; bst[1] = 0u; }
    __syncthreads();
    XcdBarrier bar; bar.bar = (unsigned*)a0.ws; bar.x = 0; bar.st = bst;
    if (phi - plo > 1) bar = xcd_barrier_post((unsigned*)a0.ws, bst);
    for (int pc = plo; pc < phi; ++pc) {
        if (pc > plo) { if (pc == plo + 1) grid.sync(); else xcd_barrier(bar); }
        unsigned char* ws = WSP; float* H = OUTP;
        bf16_t* WC = (bf16_t*)(ws + WS_WC); bf16_t* MEMB = (bf16_t*)(ws + WS_MEMB); bf16_t* WM = (bf16_t*)(ws + WS_WM); bf16_t* HB = (bf16_t*)(ws + WS_HB);
        unsigned char* S = ws + WS_S;
        int L, s, kind, j, op, sub; decode_phase(pc, L, s, kind, j, op, sub);

        if (HAS(OP_PRO) && op == OP_PRO) {
            const int gt = bidx() * 512 + tidx(), NGT = gdim() * 512;
            const float* x = IN(0); const float* mem = IN(1);
            for (int idx = gt; idx < M * D / 8; idx += NGT) { const f32x4 v0 = *(const f32x4*)(x + (size_t)idx * 8), v1 = *(const f32x4*)(x + (size_t)idx * 8 + 4);
                *(f32x4*)(H + (size_t)idx * 8) = v0; *(f32x4*)(H + (size_t)idx * 8 + 4) = v1;
                u32x4 o; o.x = pk2(v0.x, v0.y); o.y = pk2(v0.z, v0.w); o.z = pk2(v1.x, v1.y); o.w = pk2(v1.z, v1.w); *(u32x4*)(HB + (size_t)idx * 8) = o; }
            for (int idx = gt; idx < MM * D / 8; idx += NGT) { const f32x4 v0 = *(const f32x4*)(mem + (size_t)idx * 8), v1 = *(const f32x4*)(mem + (size_t)idx * 8 + 4);
                u32x4 o; o.x = pk2(v0.x, v0.y); o.y = pk2(v0.z, v0.w); o.z = pk2(v1.x, v1.y); o.w = pk2(v1.z, v1.w); *(u32x4*)(MEMB + (size_t)idx * 8) = o; }
            convert_layer(0, lds);
        }
        else if (HAS(OP_WIN) && op == OP_WIN) {
            EpiT<1> E{{(bf16_t*)S, (bf16_t*)(S + 192 * MiB), DP, nullptr, nullptr, 1.f, 0}};
            run_gemm(lds, HB, WM, M, 2 * DP, D, 1 << 30, 0, E);
        }
        else if (HAS(OP_CONV) && op == OP_CONV) { conv_phase((const bf16_t*)(S + 192 * MiB), (bf16_t*)(S + 96 * MiB), IN(5) + (size_t)j * 4 * DR, IN(6) + (size_t)j * DR); }
        else if (HAS(OP_GATES) && op == OP_GATES) {
            EpiT<2> E{{(bf16_t*)(S + 192 * MiB), nullptr, 2 * DP, IN(8) + (size_t)j * 2 * DR, nullptr, 1.f, 0}};
            run_gemm(lds, (const bf16_t*)(S + 96 * MiB), WM + 6 * MiB / 2, M, 2 * DP, DP, 1 << 30, 0, E);
        }
        else if (HAS(OP_SCAN) && op == OP_SCAN) { scan_phase(lds, (const bf16_t*)(S + 192 * MiB), (const bf16_t*)(S + 96 * MiB), (bf16_t*)S, IN(9) + (size_t)j * DR); }
        else if (HAS(OP_RES) && op == OP_RES) {
            const bf16_t* A; const bf16_t* Bt; int K;
            if (sub == 0) {
                if (kind == 0) { A = (const bf16_t*)S; Bt = WM + 15 * MiB / 2; K = DP; }
                else if (kind == 1) { A = HB; Bt = WM + 10 * MiB / 2; K = D; }
                else { A = (const bf16_t*)(S + 192 * MiB); Bt = WM + 6 * MiB / 2; K = D; }
            } else if (sub == 1) { A = (const bf16_t*)(S + 64 * MiB); Bt = WC + WC_O / 2; K = D; }
            else { A = (const bf16_t*)S; Bt = WC + WC_W2 / 2; K = FF; }
            EpiRes E{H};
            run_gemm(lds, A, Bt, M, D, K, 1 << 30, 0, E);
        }
        else if (HAS(OP_LN) && op == OP_LN) {
            ln_phase(H, HB, IN(2) + (size_t)(L * 3 + sub) * D, IN(3) + (size_t)(L * 3 + sub) * D);
            if (sub == 2 && L < 3) convert_layer(L + 1, lds);
        }
        else if (HAS(OP_PREP) && op == OP_PREP) { prep_phase(H, (bf16_t*)S, IN(11) + (size_t)j * 6 * D, sub); }
        else if (HAS(OP_L1) && op == OP_L1) {
            EpiT<3> E{{HB, nullptr, 256, nullptr, nullptr, 1.f, 0}};
            run_gemm(lds, (const bf16_t*)S, WM + 6 * MiB / 2, M, 256, 3 * D, 1 << 30, 0, E);
        }
        else if (HAS(OP_L2) && op == OP_L2) {
            EpiT<4> E{{(bf16_t*)S, nullptr, 3 * D, IN(15) + (size_t)j * D, IN(18) + (size_t)j * D, 1.f, 0}};
            run_gemm(lds, HB, WM + 8 * MiB / 2, M, 3 * D, 256, 1 << 30, 0, E);
        }
        else if (HAS(OP_REC) && op == OP_REC) { rwkv_rec_phase(lds, (const bf16_t*)(S + 192 * MiB), (const bf16_t*)S, HB, IN(23) + (size_t)j * D, IN(24) + (size_t)j * D, IN(25) + (size_t)j * D, IN(26) + (size_t)j * D, IN(27) + (size_t)j * D); }
        else if (HAS(OP_PLAIN) && op == OP_PLAIN) {
            const int ng = sub == 0 ? 1 : (sub == 1 ? 2 : 3);
            for (int g = 0; g < ng; ++g) {
                const bf16_t* A; const bf16_t* Bt; int M_, N_, asplit = 1 << 30; size_t astride = 0; EpiP P{nullptr, nullptr, 0, nullptr, nullptr, 1.f, 0};
                if (sub == 0) { A = (const bf16_t*)S; Bt = WM; M_ = M; N_ = 3 * D; asplit = 4; astride = (size_t)M * D * 2; P.O = (bf16_t*)(S + 192 * MiB); P.ldc = 3 * D; }
                else if (sub == 1) {
                    if (g == 0) { A = HB; Bt = WM; M_ = M; N_ = 2 * D; P.O = (bf16_t*)S; P.ldc = 2 * D; P.scale = 0.125f; P.scale_cols = D; }
                    else { A = WM + 4 * MiB / 2; Bt = HB; M_ = D; N_ = M; P.O = (bf16_t*)(S + 128 * MiB); P.ldc = M; }
                } else {
                    if (g == 0) { A = HB; Bt = WC + WC_Q / 2; M_ = M; N_ = D; P.O = (bf16_t*)S; P.ldc = D; P.scale = 0.0625f; P.scale_cols = D; }
                    else if (g == 1) { A = MEMB; Bt = WC + WC_K / 2; M_ = MM; N_ = D; P.O = WM; P.ldc = D; }
                    else { A = WC + WC_V / 2; Bt = MEMB; M_ = D; N_ = MM; P.O = WM + 8 * MiB / 2; P.ldc = MM; }
                }
                EpiT<0> E{P};
                run_gemm(lds, A, Bt, M_, N_, D, asplit, astride, E);
            }
        }
        else if (HAS(OP_CATT) && op == OP_CATT) { chunk_attn_phase((const bf16_t*)S, (const bf16_t*)(S + 128 * MiB), (bf16_t*)(S + 192 * MiB), IN(30) + (size_t)j * 16 * 257); }
        else if (HAS(OP_XATT) && op == OP_XATT) { mem_attn_phase((const bf16_t*)S, WM, WM + 8 * MiB / 2, (bf16_t*)(S + 64 * MiB)); }
        else if (HAS(OP_MLP1) && op == OP_MLP1) {
            EpiT<5> E{{(bf16_t*)S, nullptr, FF, nullptr, nullptr, 1.f, 0}};
            run_gemm(lds, HB, WC + WC_W1 / 2, M, FF, D, 1 << 30, 0, E);
        }
    }
}

#ifndef MK_COOP
#define MK_COOP 0
#endif
template <unsigned MASK> static void launch_one(const Args& a, hipStream_t stream) {
    static bool attr = false;
    if (!attr) { attr = true; if (hipFuncSetAttribute((const void*)fwd<MASK>, hipFuncAttributeMaxDynamicSharedMemorySize, LDS_BYTES) != hipSuccess) fprintf(stderr, "kernel_launch: hipFuncSetAttribute failed\n"); }
    hipLaunchKernelGGL(fwd<MASK>, dim3(256), dim3(512), LDS_BYTES, stream, a);
}
extern "C" void kernel_launch(void* const* d_in, const int* in_sizes, int n_in, void* d_out, int out_size, void* d_ws, size_t ws_size, hipStream_t stream) {
    static int ready = 0;
    if (ready == 0) {
        ready = 1;
        if (n_in != 37 || out_size != M * D || ws_size < WS_END) { fprintf(stderr, "kernel_launch: unexpected shapes: n_in %d out %d ws %zu (need %zu)\n", n_in, out_size, ws_size, (size_t)WS_END); ready = -1; }
    }
    if (ready < 0) return;
    Args a{};
    for (int i = 0; i < 37; ++i) a.in[i] = (const float*)d_in[i];
    a.out = (float*)d_out; a.ws = (unsigned char*)d_ws;
#if MK_COOP
    static bool attr = false;
    if (!attr) { attr = true; if (hipFuncSetAttribute((const void*)fwd<0xFFFFFFFFu>, hipFuncAttributeMaxDynamicSharedMemorySize, LDS_BYTES) != hipSuccess) fprintf(stderr, "kernel_launch: hipFuncSetAttribute failed\n"); }
    a.lo = 0; a.hi = NPHASE;
    if (hipMemsetAsync(d_ws, 0, 16384, stream) != hipSuccess) fprintf(stderr, "kernel_launch: memset of barrier words failed\n");
    void* args[] = {&a};
    hipError_t e = hipLaunchCooperativeKernel((const void*)fwd<0xFFFFFFFFu>, dim3(256), dim3(512), args, LDS_BYTES, stream);
    if (e != hipSuccess) fprintf(stderr, "kernel_launch: cooperative launch failed: %s\n", hipGetErrorString(e));
#else
    for (int pc = 0; pc < NPHASE; ++pc) {
        a.lo = pc; a.hi = pc + 1;
        int L, s, kind, j, op, sub; decode_phase(pc, L, s, kind, j, op, sub);
        switch (op) {
            case OP_PRO: launch_one<1u << OP_PRO>(a, stream); break;
            case OP_WIN: launch_one<1u << OP_WIN>(a, stream); break;
            case OP_CONV: launch_one<1u << OP_CONV>(a, stream); break;
            case OP_GATES: launch_one<1u << OP_GATES>(a, stream); break;
            case OP_SCAN: launch_one<1u << OP_SCAN>(a, stream); break;
            case OP_RES: launch_one<1u << OP_RES>(a, stream); break;
            case OP_LN: launch_one<1u << OP_LN>(a, stream); break;
            case OP_PREP: launch_one<1u << OP_PREP>(a, stream); break;
            case OP_L1: launch_one<1u << OP_L1>(a, stream); break;
            case OP_PLAIN: launch_one<1u << OP_PLAIN>(a, stream); break;
            case OP_L2: launch_one<1u << OP_L2>(a, stream); break;
            case OP_REC: launch_one<1u << OP_REC>(a, stream); break;
            case OP_CATT: launch_one<1u << OP_CATT>(a, stream); break;
            case OP_XATT: launch_one<1u << OP_XATT>(a, stream); break;
            default: launch_one<1u << OP_MLP1>(a, stream); break;
        }
    }
#endif
}
```

```cpp
#include <hip/hip_runtime.h>
#include <hip/hip_cooperative_groups.h>
#include <cstdio>
#include <cstdint>
namespace cg = cooperative_groups;
__device__ __forceinline__ int tidx() { int t = (int)threadIdx.x; asm volatile("" : "+v"(t)); return t; }
__device__ __forceinline__ int bidx() { int t = (int)blockIdx.x; asm volatile("" : "+s"(t)); return t; }
__device__ __forceinline__ int gdim() { int t = (int)gridDim.x; asm volatile("" : "+s"(t)); return t; }
#define MK_COOP 1
namespace pg8 {
#define PG8_LAS __attribute__((address_space(3)))
typedef unsigned short bf16_t;
typedef short bf16x8 __attribute__((ext_vector_type(8)));
typedef float f32x4 __attribute__((ext_vector_type(4)));
typedef unsigned u32x4 __attribute__((ext_vector_type(4)));
constexpr int BM = 256, BK = 64, HALF = 128, HTB = HALF * BK * 2  , STAGE_BYTES = 8 * HTB, NXCD = 8, WGM = 8;

__host__ __device__ __forceinline__ int lds_byte(int r, int c) { const int st = (r >> 4) * 2 + (c >> 5), rr = r & 15, cc = c & 31, ob = rr * 64 + cc * 2; return st * 1024 + (ob ^ (((ob >> 9) & 1) << 5)); }
__host__ __device__ __forceinline__ void stage_rc(int b, int& R, int& C) { const int st = b / 1024, sb = b % 1024, swz = sb ^ (((sb >> 9) & 1) << 5); R = (st >> 1) * 16 + swz / 64; C = (st & 1) * 32 + (swz % 64) / 2; }
__host__ __device__ __forceinline__ int perm32(int rho) { const int n = rho >> 4, i = rho & 15; return 8 * (i >> 2) + 4 * n + (i & 3); }

struct Unit { int pm, pn, k0, nt; };
struct Gemm { const bf16_t* A; const bf16_t* Bt; int M, N, K; int asplit; size_t astride; };

struct StaticOrder {
    int nM, nN, nwg, G, c, kwin, ntfull;
    __host__ __device__ void init(int M, int N, int G_, int c_) { nM = M / BM; nN = N / BM; nwg = nM * nN; G = G_; c = c_; }
    __host__ __device__ bool next(int i, Unit& u) const {
        const long L = (long)i * G + c; if (L >= nwg) return false;
        int wgid = (int)L; { const int q = nwg / NXCD, r = nwg % NXCD, xcd = wgid % NXCD, off = wgid / NXCD; wgid = (xcd < r ? xcd * (q + 1) : r * (q + 1) + (xcd - r) * q) + off; }
        const int nig = WGM * nN, gid = wgid / nig, fm = gid * WGM, gsz = (nM - fm) < WGM ? (nM - fm) : WGM;
        u.pm = fm + ((wgid % nig) % gsz); u.pn = (wgid % nig) / gsz; u.k0 = 0; u.nt = ntfull;
        if (kwin == 1) { const int p = u.pn % 6, clo = 256 * p, chi = (clo + 255 < 1343) ? clo + 255 : 1343; const int klo = 84 * (clo / 84), khi = 84 * (chi / 84 + 1);
            int tlo = klo / 64, thi = (khi + 63) / 64; if ((thi - tlo) & 1) { if (thi < ntfull) ++thi; else --tlo; } u.k0 = tlo; u.nt = thi - tlo; }
        return true;
    }
    __device__ __forceinline__ void a_ready(const Unit&) const {}
    __device__ __forceinline__ void done(const Unit&) const {}
};

__device__ __forceinline__ unsigned cvt_pk_bf16(float lo, float hi) { unsigned r; asm volatile("v_cvt_pk_bf16_f32 %0, %1, %2" : "=v"(r) : "v"(lo), "v"(hi)); return r; }
typedef float f32x2 __attribute__((ext_vector_type(2)));
template <class Epi, class Sched, bool ALIGN_EPI = false, bool SP2 = false>
__device__ __forceinline__ void gemm_phase(PG8_LAS unsigned char* lds, const Gemm g, const Sched& S, const Epi& E) {
    const int tid = tidx(), wid = __builtin_amdgcn_readfirstlane(tid >> 6), lane = tid & 63, wr = wid >> 2, wc = wid & 3, fr = lane & 15, fq = lane >> 4;
    const int K = g.K, nt = K / BK;
    unsigned voffA[2], voffB[2];
#pragma unroll
    for (int i = 0; i < 2; ++i) { int R, C; stage_rc(tid * 16 + i * 8192, R, C); const int Rb = Epi::PERM ? ((R & ~31) + perm32(R & 31)) : R;
        voffA[i] = (unsigned)(R * K + C) * 2u; voffB[i] = (unsigned)(Rb * K + C) * 2u; }
    const size_t kstep = (size_t)(BK * 2);
    const size_t hstep = (size_t)HALF * K * 2;
    const size_t tstep = 2 * hstep;
    const unsigned ldsw = (unsigned)wid * 1024u;
    const int aoff = lds_byte(wr * 64 + fr, fq * 8), boff = lds_byte(wc * 32 + fr, fq * 8);
#define PG8_SA(b, h) (((b) * 2 + (h)) * HTB)
#define PG8_SB(b, h) ((4 + (b) * 2 + (h)) * HTB)
#define PG8_STAGE(bufoff, gbase, voff) do { _Pragma("unroll") for (int _i = 0; _i < 2; ++_i) \
        __builtin_amdgcn_global_load_lds((const unsigned*)((const char*)(gbase) + (voff)[_i]), (PG8_LAS unsigned*)(lds + (bufoff) + ldsw + _i * 8192), 16, 0, 0); } while (0)
#define PG8_LDA(dst, b, h) do { _Pragma("unroll") for (int m = 0; m < 4; ++m) _Pragma("unroll") for (int k = 0; k < 2; ++k) dst[m][k] = *(const PG8_LAS bf16x8*)(lds + PG8_SA(b, h) + aoff + m * 2048 + k * 1024); } while (0)
#define PG8_LDB(dst, b, h) do { _Pragma("unroll") for (int n = 0; n < 2; ++n) _Pragma("unroll") for (int k = 0; k < 2; ++k) dst[n][k] = *(const PG8_LAS bf16x8*)(lds + PG8_SB(b, h) + boff + n * 2048 + k * 1024); } while (0)
#define PG8_MMA(ai, bj, At, Bt) do { __builtin_amdgcn_s_setprio(1); _Pragma("unroll") for (int m = 0; m < 4; ++m) _Pragma("unroll") for (int n = 0; n < 2; ++n) _Pragma("unroll") for (int k = 0; k < 2; ++k) \
        acc[ai][bj][m][n] = __builtin_amdgcn_mfma_f32_16x16x32_bf16(Bt[n][k], At[m][k], acc[ai][bj][m][n], 0, 0, 0); __builtin_amdgcn_s_setprio(0); } while (0)
#define PG8_WAIT_V(n) asm volatile("s_waitcnt vmcnt(" #n ")" ::: "memory")
#define PG8_WAIT_L(n) asm volatile("s_waitcnt lgkmcnt(" #n ")" ::: "memory")
#define PG8_BAR __builtin_amdgcn_s_barrier()
#define PG8_SCHED __builtin_amdgcn_sched_barrier(0)
    Unit cur, nxt; int ui = 0;
    if (!S.next(0, cur)) return;
    f32x4 acc[2][2][4][2];
#pragma unroll
    for (int a = 0; a < 2; ++a)
#pragma unroll
        for (int b = 0; b < 2; ++b)
#pragma unroll
            for (int m = 0; m < 4; ++m)
#pragma unroll
                for (int n = 0; n < 2; ++n) acc[a][b][m][n] = (f32x4){0.f, 0.f, 0.f, 0.f};
    bf16x8 At[4][2], B0[2][2], B1[2][2];
    const char* cA = (const char*)g.A + (size_t)(cur.pn / g.asplit) * g.astride + (size_t)cur.pm * tstep + (size_t)cur.k0 * kstep; const char* cB = (const char*)g.Bt + (size_t)cur.pn * tstep + (size_t)cur.k0 * kstep;
    S.a_ready(cur);
    if constexpr (SP2) {
        PG8_STAGE(PG8_SB(0, 0), cB, voffB); PG8_STAGE(PG8_SB(0, 1), cB + hstep, voffB); PG8_STAGE(PG8_SA(0, 0), cA, voffA); PG8_STAGE(PG8_SA(0, 1), cA + hstep, voffA);
        if (wr == 1) PG8_BAR;
        PG8_WAIT_V(2); PG8_BAR;
        PG8_STAGE(PG8_SB(1, 0), cB + kstep, voffB); PG8_STAGE(PG8_SA(1, 0), cA + kstep, voffA); PG8_STAGE(PG8_SB(1, 1), cB + hstep + kstep, voffB);
        PG8_WAIT_V(6); PG8_BAR;
    } else {
        PG8_STAGE(PG8_SB(0, 0), cB, voffB); PG8_STAGE(PG8_SA(0, 0), cA, voffA); PG8_STAGE(PG8_SB(0, 1), cB + hstep, voffB); PG8_STAGE(PG8_SA(0, 1), cA + hstep, voffA);
        if (wr == 1) PG8_BAR;
        PG8_WAIT_V(4); PG8_BAR;
        PG8_STAGE(PG8_SB(1, 0), cB + kstep, voffB); PG8_STAGE(PG8_SA(1, 0), cA + kstep, voffA); PG8_STAGE(PG8_SB(1, 1), cB + hstep + kstep, voffB);
        PG8_WAIT_V(6); PG8_BAR;
    }
    for (;;) {
        const bool has_next = S.next(ui + 1, nxt);
        const char* nA = has_next ? (const char*)g.A + (size_t)(nxt.pn / g.asplit) * g.astride + (size_t)nxt.pm * tstep + (size_t)nxt.k0 * kstep : cA; const char* nB = has_next ? (const char*)g.Bt + (size_t)nxt.pn * tstep + (size_t)nxt.k0 * kstep : cB;
        const int unt = cur.nt;
        for (int t = 0; t < unt; t += 2) {
            const bool last = (t == unt - 2);
            const char* a1 = cA + (size_t)(t + 1) * kstep;
            const char* a2 = last ? nA : cA + (size_t)(t + 2) * kstep; const char* b2 = last ? nB : cB + (size_t)(t + 2) * kstep;
            const char* a3 = a2 + kstep; const char* b3 = b2 + kstep;
            if (last && has_next) S.a_ready(nxt);
            if constexpr (SP2) {
            PG8_LDB(B0, 0, 0); PG8_LDB(B1, 0, 1); PG8_SCHED; PG8_LDA(At, 0, 0); PG8_STAGE(PG8_SA(1, 1), a1 + hstep, voffA);
            PG8_WAIT_V(8); PG8_WAIT_L(0); PG8_BAR; PG8_MMA(0, 0, At, B0); PG8_MMA(0, 1, At, B1); PG8_BAR; PG8_SCHED;
            PG8_LDA(At, 0, 1); PG8_STAGE(PG8_SB(0, 0), b2, voffB); PG8_STAGE(PG8_SB(0, 1), b2 + hstep, voffB); PG8_STAGE(PG8_SA(0, 0), a2, voffA);
            PG8_WAIT_V(8); PG8_WAIT_L(0); PG8_BAR; PG8_MMA(1, 0, At, B0); PG8_MMA(1, 1, At, B1); PG8_BAR; PG8_SCHED;
            PG8_LDB(B0, 1, 0); PG8_LDB(B1, 1, 1); PG8_SCHED; PG8_LDA(At, 1, 0); PG8_STAGE(PG8_SA(0, 1), a2 + hstep, voffA);
            PG8_WAIT_V(8); PG8_WAIT_L(0); PG8_BAR; PG8_MMA(0, 0, At, B0); PG8_MMA(0, 1, At, B1); PG8_BAR; PG8_SCHED;
            PG8_LDA(At, 1, 1); PG8_STAGE(PG8_SB(1, 0), b3, voffB); PG8_STAGE(PG8_SB(1, 1), b3 + hstep, voffB); PG8_STAGE(PG8_SA(1, 0), a3, voffA);
            PG8_WAIT_V(8); PG8_WAIT_L(0); PG8_BAR; PG8_MMA(1, 0, At, B0); PG8_MMA(1, 1, At, B1); PG8_BAR; PG8_SCHED;
            } else {
            PG8_LDB(B0, 0, 0); PG8_SCHED; PG8_LDA(At, 0, 0); PG8_STAGE(PG8_SA(1, 1), a1 + hstep, voffA);
            PG8_WAIT_L(8); PG8_BAR; PG8_WAIT_L(0); PG8_MMA(0, 0, At, B0); PG8_BAR; PG8_SCHED;
            PG8_LDB(B1, 0, 1); PG8_STAGE(PG8_SB(0, 0), b2, voffB);
            PG8_BAR; PG8_WAIT_L(0); PG8_MMA(0, 1, At, B1); PG8_BAR;
            PG8_LDA(At, 0, 1); PG8_STAGE(PG8_SA(0, 0), a2, voffA);
            PG8_BAR; PG8_WAIT_L(0); PG8_MMA(1, 0, At, B0); PG8_BAR; PG8_SCHED;
            PG8_STAGE(PG8_SB(0, 1), b2 + hstep, voffB);
            PG8_WAIT_V(6); PG8_BAR; PG8_MMA(1, 1, At, B1); PG8_BAR;
            PG8_LDB(B0, 1, 0); PG8_SCHED; PG8_LDA(At, 1, 0); PG8_STAGE(PG8_SA(0, 1), a2 + hstep, voffA);
            PG8_WAIT_L(8); PG8_BAR; PG8_WAIT_L(0); PG8_MMA(0, 0, At, B0); PG8_BAR; PG8_SCHED;
            PG8_LDB(B1, 1, 1); PG8_STAGE(PG8_SB(1, 0), b3, voffB);
            PG8_BAR; PG8_WAIT_L(0); PG8_MMA(0, 1, At, B1); PG8_BAR;
            PG8_LDA(At, 1, 1); PG8_STAGE(PG8_SA(1, 0), a3, voffA);
            PG8_BAR; PG8_WAIT_L(0); PG8_MMA(1, 0, At, B0); PG8_BAR; PG8_SCHED;
            PG8_STAGE(PG8_SB(1, 1), b3 + hstep, voffB);
            PG8_WAIT_V(6); PG8_BAR; PG8_MMA(1, 1, At, B1); PG8_BAR;
            }
        }
        if constexpr (ALIGN_EPI) { if (wr == 0) PG8_BAR; }
        if constexpr (!Epi::AFTER_DRAIN) { E(acc, cur, wr, wc, fr, fq); S.done(cur); }
        if (!has_next) break;
#pragma unroll
        for (int a = 0; a < 2; ++a)
#pragma unroll
            for (int b = 0; b < 2; ++b)
#pragma unroll
                for (int m = 0; m < 4; ++m)
#pragma unroll
                    for (int n = 0; n < 2; ++n) acc[a][b][m][n] = (f32x4){0.f, 0.f, 0.f, 0.f};
        cur = nxt; cA = nA; cB = nB; ++ui;
        if constexpr (ALIGN_EPI) { if (wr == 1) PG8_BAR; }
    }
    PG8_WAIT_V(0);
    if constexpr (!ALIGN_EPI) { if (wr == 0) PG8_BAR; }
    PG8_BAR;
    if constexpr (Epi::AFTER_DRAIN) { E.fused(acc, cur, wr, wc, fr, fq, lds, wid, lane); S.done(cur); }
#undef PG8_SA
#undef PG8_SB
#undef PG8_STAGE
#undef PG8_LDA
#undef PG8_LDB
#undef PG8_MMA
#undef PG8_WAIT_V
#undef PG8_WAIT_L
#undef PG8_BAR
#undef PG8_SCHED
}
}

using pg8::bf16_t; using pg8::f32x4; using pg8::bf16x8; using pg8::u32x4;
#define LAS __attribute__((address_space(3)))
typedef unsigned u32x2 __attribute__((ext_vector_type(2)));
typedef float f32x2 __attribute__((ext_vector_type(2)));

constexpr int M = 32768, D = 1024, SEQ = 2048, NB = 16, DR = 1344, DP = 1536, FF = 4096, MEMT = 256, MM = NB * MEMT;
constexpr float ALPHA = 1.6817928305074290f, LN_EPS = 1e-5f, LOG2E = 1.4426950408889634f;
constexpr size_t MiB = 1u << 20;
constexpr size_t WS_WC = 1 * MiB, WS_MEMB = 25 * MiB, WS_WM = 33 * MiB, WS_HB = 53 * MiB, WS_S = 117 * MiB, WS_END = 501 * MiB;
constexpr size_t WC_Q = 0, WC_K = 2 * MiB, WC_V = 4 * MiB, WC_O = 6 * MiB, WC_W1 = 8 * MiB, WC_W2 = 16 * MiB;
constexpr int LDS_BYTES = 147456;
constexpr int NPHASE = 53;

__device__ __forceinline__ unsigned f2bf(float f) { unsigned u = __builtin_bit_cast(unsigned, f); return (u + 0x7fffu + ((u >> 16) & 1u)) >> 16; }
__device__ __forceinline__ unsigned pk2(float lo, float hi) { return f2bf(lo) | (f2bf(hi) << 16); }
__device__ __forceinline__ float bflo(unsigned u) { return __uint_as_float(u << 16); }
__device__ __forceinline__ float bfhi(unsigned u) { return __uint_as_float(u & 0xffff0000u); }
__device__ __forceinline__ float sigmoid_(float x) { return 1.0f / (1.0f + __expf(-x)); }
__device__ __forceinline__ float softplus_(float x) { return fmaxf(x, 0.f) + __logf(1.0f + __expf(-fabsf(x))); }
__device__ __forceinline__ float tanh_(float x) { return 1.0f - 2.0f / (1.0f + __expf(2.0f * x)); }
__device__ __forceinline__ float gelu_tanh_(float x) { return 0.5f * x * (1.0f + tanh_(0.7978845608028654f * (x + 0.044715f * x * x * x))); }

struct EpiP { bf16_t* O; bf16_t* O2; int ldc; const float* p0; const float* p1; float scale; int scale_cols; };
template <int MODE> struct EpiT {
    static constexpr bool PERM = true, AFTER_DRAIN = false; EpiP P;
    __device__ __forceinline__ void operator()(const f32x4 (&acc)[2][2][4][2], const pg8::Unit& u, int wr, int wc, int fr, int fq) const {
        const int row0 = u.pm * 256 + wr * 64 + fr;
#pragma unroll
        for (int bj = 0; bj < 2; ++bj) {
            const int col = u.pn * 256 + bj * 128 + wc * 32 + 8 * fq;
            float bias[8];
#pragma unroll
            for (int e = 0; e < 8; ++e) bias[e] = 0.f;
            bf16_t* base = P.O; int ocol = col; float sc = 1.f;
            if (MODE == 0) { sc = (col < P.scale_cols) ? P.scale : 1.f; }
            if (MODE == 1) { if (col >= DP) { base = P.O2; ocol = col - DP; } }
            if (MODE == 2) { const int g = col / DP, cc = col - g * DP; if (cc < DR) {
#pragma unroll
                    for (int e = 0; e < 8; ++e) bias[e] = P.p0[g * DR + cc + e]; } }
            if (MODE == 4) { if (col < 2048) { const float* bp = (col < 1024) ? (P.p0 + col) : (P.p1 + (col - 1024));
#pragma unroll
                    for (int e = 0; e < 8; ++e) bias[e] = bp[e]; } }
#pragma unroll
            for (int ai = 0; ai < 2; ++ai)
#pragma unroll
                for (int m = 0; m < 4; ++m) {
                    const int row = row0 + ai * 128 + m * 16;
                    float v[8];
#pragma unroll
                    for (int e = 0; e < 4; ++e) { v[e] = acc[ai][bj][m][0][e]; v[4 + e] = acc[ai][bj][m][1][e]; }
#pragma unroll
                    for (int e = 0; e < 8; ++e) {
                        float x = v[e] + bias[e];
                        if (MODE == 0) x *= sc;
                        if (MODE == 1) { if (col < DP) x = gelu_tanh_(x); }
                        if (MODE == 2) x = sigmoid_(x);
                        if (MODE == 3) { if (col < 64) x = tanh_(x); else if (col >= 128) x = sigmoid_(x); }
                        if (MODE == 4) { if (col < 1024) { const float wl = -softplus_(-x) - 0.5f; x = -__expf(wl); } else if (col < 2048) x = sigmoid_(x); }
                        if (MODE == 5) { x = fmaxf(x, 0.f); x = x * x; }
                        v[e] = x;
                    }
                    u32x4 w; w.x = pg8::cvt_pk_bf16(v[0], v[1]); w.y = pg8::cvt_pk_bf16(v[2], v[3]); w.z = pg8::cvt_pk_bf16(v[4], v[5]); w.w = pg8::cvt_pk_bf16(v[6], v[7]);
                    *(u32x4*)(base + (size_t)row * P.ldc + ocol) = w;
                    asm volatile("" ::: "memory");
                }
        }
    }
};
struct EpiRes {
    static constexpr bool PERM = true, AFTER_DRAIN = false; float* out;
    __device__ __forceinline__ void operator()(const f32x4 (&acc)[2][2][4][2], const pg8::Unit& u, int wr, int wc, int fr, int fq) const {
        const int row0 = u.pm * 256 + wr * 64 + fr;
#pragma unroll
        for (int bj = 0; bj < 2; ++bj) {
            const int col = u.pn * 256 + bj * 128 + wc * 32 + 8 * fq;
#pragma unroll
            for (int ai = 0; ai < 2; ++ai)
#pragma unroll
                for (int m = 0; m < 4; ++m) {
                    float* p = out + (size_t)(row0 + ai * 128 + m * 16) * D + col;
                    f32x4 b0 = *(const f32x4*)p, b1 = *(const f32x4*)(p + 4);
                    b0 = b0 * ALPHA + acc[ai][bj][m][0]; b1 = b1 * ALPHA + acc[ai][bj][m][1];
                    *(f32x4*)p = b0; *(f32x4*)(p + 4) = b1;
                    if (m & 1) asm volatile("" ::: "memory");
                }
        }
    }
};

template <class Epi> __device__ __forceinline__ void run_gemm(LAS unsigned char* lds, const bf16_t* A, const bf16_t* Bt, int M_, int N_, int K_, int asplit, size_t astride, const Epi& E, int kwin = 0) {
    asm volatile("" : "+s"(K_));
    pg8::Gemm g{A, Bt, M_, N_, K_, asplit, astride}; pg8::StaticOrder S; S.init(M_, N_, gdim(), bidx()); S.kwin = kwin; S.ntfull = K_ / 64;
    pg8::gemm_phase<Epi, pg8::StaticOrder, true, true>(lds, g, S, E);
}

__device__ __forceinline__ void tr_item(const float* W, int ldn, int c0, int N, bf16_t* WT, int ldw, int row_off, int koff, LAS float* scr, int item, int lane) {
    const int nblk = N / 32, kb = item / nblk, nb = item % nblk, k0 = 64 * kb, n0 = 32 * nb;
#pragma unroll 8
    for (int i = 0; i < 32; ++i) { const int kk = 2 * i + (lane >> 5); scr[kk * 33 + (lane & 31)] = W[(size_t)(k0 + kk) * ldn + c0 + n0 + (lane & 31)]; }
    asm volatile("s_waitcnt lgkmcnt(0)" ::: "memory");
    const int c = lane & 7;
#pragma unroll
    for (int j = 0; j < 4; ++j) { const int n = (lane >> 3) + 8 * j; const LAS float* s = scr + (8 * c) * 33 + n;
        u32x4 o; o.x = pk2(s[0 * 33], s[1 * 33]); o.y = pk2(s[2 * 33], s[3 * 33]); o.z = pk2(s[4 * 33], s[5 * 33]); o.w = pk2(s[6 * 33], s[7 * 33]);
        *(u32x4*)(WT + (size_t)(row_off + n0 + n) * ldw + koff + k0 + 8 * c) = o; }
    asm volatile("s_waitcnt lgkmcnt(0)" ::: "memory");
}
#define TRJOB(W, ldn, c0, K, N, WT, ldw, roff, koff) { const int cnt_ = ((K) / 64) * ((N) / 32); if (r < cnt_) { tr_item(W, ldn, c0, N, WT, ldw, roff, koff, scr, r, lane); continue; } r -= cnt_; }

struct Args { const float* in[37]; float* out; unsigned char* ws; int lo, hi; };
constexpr int TAB_OFF = 131072 + 1024;
__device__ __forceinline__ const float* ldp(LAS unsigned char* lds, int i) {
    volatile LAS unsigned* t = (volatile LAS unsigned*)(lds + TAB_OFF) + 2 * i;
    const unsigned lo = (unsigned)__builtin_amdgcn_readfirstlane((int)t[0]), hi = (unsigned)__builtin_amdgcn_readfirstlane((int)t[1]);
    return (const float*)(((unsigned long long)hi << 32) | (unsigned long long)lo);
}
#define IN(i) ldp(lds, (i))
#define WSP ((unsigned char*)ldp(lds, 38))
#define OUTP ((float*)ldp(lds, 37))

__device__ __forceinline__ void convert_layer(int L, LAS unsigned char* lds) {
    const int tid = tidx(), lane = tid & 63, wave = tid >> 6;
    const int gw = bidx() * 8 + wave, NGW = gdim() * 8;
    LAS float* scr = (LAS float*)(lds + wave * 16384);
    unsigned char* wsp_ = WSP; bf16_t* WC = (bf16_t*)(wsp_ + WS_WC); bf16_t* WM = (bf16_t*)(wsp_ + WS_WM);
    const int kind = L % 3, j = L / 3;
    const float* wq = IN(32) + (size_t)L * D * D; const float* wkv = IN(33) + (size_t)L * D * 2 * D; const float* wo = IN(34) + (size_t)L * D * D;
    const float* w1 = IN(35) + (size_t)L * D * FF; const float* w2 = IN(36) + (size_t)L * FF * D;
    for (int it = gw;; it += NGW) {
        int r = it;
        TRJOB(wq, D, 0, D, D, WC + WC_Q / 2, D, 0, 0)
        TRJOB(wkv, 2 * D, 0, D, D, WC + WC_K / 2, D, 0, 0)
        TRJOB(wkv, 2 * D, D, D, D, WC + WC_V / 2, D, 0, 0)
        TRJOB(wo, D, 0, D, D, WC + WC_O / 2, D, 0, 0)
        TRJOB(w1, FF, 0, D, FF, WC + WC_W1 / 2, D, 0, 0)
        TRJOB(w2, D, 0, FF, D, WC + WC_W2 / 2, FF, 0, 0)
        if (kind == 0) {
            const float* win = IN(4) + (size_t)j * D * 2 * DR; const float* wout = IN(10) + (size_t)j * DR * D;
            TRJOB(win, 2 * DR, 0, D, DR, WM, D, 0, 0)
            TRJOB(win, 2 * DR, DR, D, DR, WM, D, DP, 0)
            TRJOB(wout, D, 0, DR, D, WM + 15 * MiB / 2, DP, 0, 0)
        } else if (kind == 1) {
            const float* wr = IN(12) + (size_t)j * D * D; const float* wk = IN(13) + (size_t)j * D * D; const float* wv = IN(14) + (size_t)j * D * D; const float* wo2 = IN(28) + (size_t)j * D * D;
            TRJOB(wr, D, 0, D, D, WM, D, 0, 0)
            TRJOB(wk, D, 0, D, D, WM, D, D, 0)
            TRJOB(wv, D, 0, D, D, WM, D, 2 * D, 0)
            TRJOB(wo2, D, 0, D, D, WM + 10 * MiB / 2, D, 0, 0)
        } else {
            const float* wqkv = IN(29) + (size_t)j * D * 3 * D; const float* wo2 = IN(31) + (size_t)j * D * D;
            TRJOB(wqkv, 3 * D, 0, D, 2 * D, WM, D, 0, 0)
            TRJOB(wqkv, 3 * D, 2 * D, D, D, WM + 4 * MiB / 2, D, 0, 0)
            TRJOB(wo2, D, 0, D, D, WM + 6 * MiB / 2, D, 0, 0)
        }
        break;
    }
    const int gt = bidx() * 512 + tid, NGT = gdim() * 512;
    if (kind == 0) {
        const float* gwt = IN(7) + (size_t)j * 2 * 16 * 84 * 84;
        bf16_t* GW = WM + 6 * MiB / 2;
        for (int idx = gt; idx < 3072 * (DP / 8); idx += NGT) {
            const int n = idx / (DP / 8), k0 = (idx % (DP / 8)) * 8; const int g = n / DP, cc = n % DP; float v[8];
#pragma unroll
            for (int e = 0; e < 8; ++e) { const int k = k0 + e; v[e] = (cc < DR && k < DR && (cc / 84) == (k / 84)) ? gwt[(((size_t)g * 16 + cc / 84) * 84 + (k % 84)) * 84 + (cc % 84)] : 0.f; }
            u32x4 o; o.x = pk2(v[0], v[1]); o.y = pk2(v[2], v[3]); o.z = pk2(v[4], v[5]); o.w = pk2(v[6], v[7]);
            *(u32x4*)(GW + (size_t)n * DP + k0) = o;
        }
        for (int idx = gt; idx < 2 * 192 * (D / 8); idx += NGT) {
            const int rr = idx / (D / 8), k0 = (idx % (D / 8)) * 8; const int n = (rr < 192) ? (DR + rr) : (DP + DR + rr - 192);
            *(u32x4*)(WM + (size_t)n * D + k0) = (u32x4){0u, 0u, 0u, 0u};
        }
        bf16_t* WOUT = WM + 15 * MiB / 2;
        for (int idx = gt; idx < D * 24; idx += NGT) {
            const int n = idx / 24, k0 = DR + (idx % 24) * 8;
            *(u32x4*)(WOUT + (size_t)n * DP + k0) = (u32x4){0u, 0u, 0u, 0u};
        }
    } else if (kind == 1) {
        const float* w1_ = IN(16) + (size_t)j * D * 64; const float* a1_ = IN(19) + (size_t)j * D * 64; const float* g1_ = IN(21) + (size_t)j * D * 128;
        const float* w2_ = IN(17) + (size_t)j * 64 * D; const float* a2_ = IN(20) + (size_t)j * 64 * D; const float* g2_ = IN(22) + (size_t)j * 128 * D;
        bf16_t* WL1 = WM + 6 * MiB / 2; bf16_t* WL2 = WM + 8 * MiB / 2;
        for (int idx = gt; idx < 256 * (3072 / 8); idx += NGT) {
            const int n = idx / 384, k0 = (idx % 384) * 8; float v[8];
#pragma unroll
            for (int e = 0; e < 8; ++e) { const int k = k0 + e; float x = 0.f;
                if (n < 64) { if (k < 1024) x = w1_[(size_t)k * 64 + n]; }
                else if (n < 128) { if (k >= 1024 && k < 2048) x = a1_[(size_t)(k - 1024) * 64 + (n - 64)]; }
                else { if (k >= 2048) x = g1_[(size_t)(k - 2048) * 128 + (n - 128)]; }
                v[e] = x; }
            u32x4 o; o.x = pk2(v[0], v[1]); o.y = pk2(v[2], v[3]); o.z = pk2(v[4], v[5]); o.w = pk2(v[6], v[7]);
            *(u32x4*)(WL1 + (size_t)n * 3072 + k0) = o;
        }
        for (int idx = gt; idx < 3072 * 32; idx += NGT) {
            const int n = idx / 32, k0 = (idx % 32) * 8; float v[8];
#pragma unroll
            for (int e = 0; e < 8; ++e) { const int k = k0 + e; float x = 0.f;
                if (n < 1024) { if (k < 64) x = w2_[(size_t)k * D + n]; }
                else if (n < 2048) { if (k >= 64 && k < 128) x = a2_[(size_t)(k - 64) * D + (n - 1024)]; }
                else { if (k >= 128) x = g2_[(size_t)(k - 128) * D + (n - 2048)]; }
                v[e] = x; }
            u32x4 o; o.x = pk2(v[0], v[1]); o.y = pk2(v[2], v[3]); o.z = pk2(v[4], v[5]); o.w = pk2(v[6], v[7]);
            *(u32x4*)(WL2 + (size_t)n * 256 + k0) = o;
        }
    }
}

__device__ __forceinline__ void ln_phase(float* H, bf16_t* HB, const float* g, const float* b) {
    const int tid = tidx(), lane = tid & 63, wave = tid >> 6;
    const int gw = bidx() * 8 + wave, NGW = gdim() * 8;
    f32x4 gv[4], bv[4];
#pragma unroll
    for (int j = 0; j < 4; ++j) { gv[j] = *(const f32x4*)(g + 256 * j + 4 * lane); bv[j] = *(const f32x4*)(b + 256 * j + 4 * lane); }
    for (int m = gw; m < M; m += NGW) {
        float* row = H + (size_t)m * D + 4 * lane; f32x4 v[4]; float s = 0.f;
#pragma unroll
        for (int j = 0; j < 4; ++j) { v[j] = *(const f32x4*)(row + 256 * j); s += (v[j].x + v[j].y) + (v[j].z + v[j].w); }
#pragma unroll
        for (int o = 1; o < 64; o <<= 1) s += __shfl_xor(s, o);
        const float mean = s * (1.f / D); float s2 = 0.f;
#pragma unroll
        for (int j = 0; j < 4; ++j) { v[j] = v[j] - mean; s2 += (v[j].x * v[j].x + v[j].y * v[j].y) + (v[j].z * v[j].z + v[j].w * v[j].w); }
#pragma unroll
        for (int o = 1; o < 64; o <<= 1) s2 += __shfl_xor(s2, o);
        const float rstd = 1.f / sqrtf(s2 * (1.f / D) + LN_EPS);
        bf16_t* hb = HB + (size_t)m * D + 4 * lane;
#pragma unroll
        for (int j = 0; j < 4; ++j) { const f32x4 y = v[j] * rstd * gv[j] + bv[j]; *(f32x4*)(row + 256 * j) = y;
            u32x2 w; w.x = pk2(y.x, y.y); w.y = pk2(y.z, y.w); *(u32x2*)(hb + 256 * j) = w; }
    }
}
#define XB_TMO      128
#define XB_XCNT(j)  (256  + 64 * (j))
#define XB_XSUB(j)  (1280 + 64 * (j))
#define XB_XGEN(j)  (2304 + 64 * (j))
#define XB_TOP      3328
#define XB_TOPGEN   3392
#define XCD_BAR_WORDS 3456
#define XB_SPIN_CAP (1u << 18)

__device__ __forceinline__ unsigned xb_ld(unsigned* p)              { return __hip_atomic_load(p, __ATOMIC_RELAXED, __HIP_MEMORY_SCOPE_AGENT); }
__device__ __forceinline__ unsigned xb_add(unsigned* p, unsigned v) { return __hip_atomic_fetch_add(p, v, __ATOMIC_RELAXED, __HIP_MEMORY_SCOPE_AGENT); }
__device__ __forceinline__ unsigned xb_xcc_id() { return (unsigned)__builtin_amdgcn_s_getreg((3 << 11) | 20) & 0xFu; }
#define XB_SPIN(cond, bar) do { unsigned _sp = 0; while (cond) { __builtin_amdgcn_s_sleep(1); \
    if ((++_sp & 255u) == 0u) { if (xb_ld(&(bar)[XB_TMO])) break; if (_sp > XB_SPIN_CAP) { atomicAdd(&(bar)[XB_TMO], 1u); break; } } } } while (0)

struct XcdBarrier {
    unsigned* bar; unsigned x;
    volatile LAS unsigned* st;
};

__device__ __forceinline__ XcdBarrier xcd_barrier_post(unsigned* bar, volatile LAS unsigned* st) {
    XcdBarrier b; b.bar = bar; b.x = xb_xcc_id(); b.st = st;
    if (tidx() == 0) (void)xb_add(&bar[XB_XCNT(b.x)], 1u);
    return b;
}
__device__ __forceinline__ void xcd_barrier_complete(unsigned* bar, unsigned x, unsigned& nloc, unsigned& nx) {
    const unsigned G = gridDim.x * gridDim.y * gridDim.z;
    unsigned sum, cnt, mine, sp = 0u;
    for (;;) {
        sum = 0u; cnt = 0u; mine = 0u;
#pragma unroll
        for (unsigned j = 0; j < 16; ++j) { const unsigned c = xb_ld(&bar[XB_XCNT(j)]); sum += c; cnt += (c > 0u) ? 1u : 0u; mine = (j == x) ? c : mine; }
        if (sum == G) break;
        __builtin_amdgcn_s_sleep(1);
        if ((++sp & 255u) == 0u) { if (xb_ld(&bar[XB_TMO])) break; if (sp > XB_SPIN_CAP) { atomicAdd(&bar[XB_TMO], 1u); break; } }
    }
    nloc = mine > 0u ? mine : 1u; nx = cnt > 0u ? cnt : 1u;
}

__device__ __forceinline__ void xcd_barrier(const XcdBarrier& b) {
    asm volatile("s_waitcnt vmcnt(0)" ::: "memory");
    __syncthreads();
    if (tidx() == 0) {
        unsigned* bar = b.bar;
        __builtin_amdgcn_s_waitcnt(0);
        unsigned nloc = b.st[0], nx = b.st[1];
        if (nloc == 0u) { xcd_barrier_complete(bar, b.x, nloc, nx); b.st[0] = nloc; b.st[1] = nx; }
        const unsigned old = xb_add(&bar[XB_XSUB(b.x)], 1u);
        const unsigned gen = old / nloc;
        if (old + 1u == (gen + 1u) * nloc) {
            __builtin_amdgcn_fence(__ATOMIC_RELEASE, "agent");
            asm volatile("s_waitcnt vmcnt(0)" ::: "memory");
            const unsigned og = xb_add(&bar[XB_TOP], 1u);
            const unsigned tg = og / nx;
            if (og + 1u == (tg + 1u) * nx) xb_add(&bar[XB_TOPGEN], 1u);
            else XB_SPIN(xb_ld(&bar[XB_TOPGEN]) == tg, bar);
            __builtin_amdgcn_fence(__ATOMIC_ACQUIRE, "agent");
            xb_add(&bar[XB_XGEN(b.x)], 1u);
            asm volatile("s_waitcnt vmcnt(0)" ::: "memory");
        } else {
            XB_SPIN(xb_ld(&bar[XB_XGEN(b.x)]) == gen, bar);
            __builtin_amdgcn_fence(__ATOMIC_ACQUIRE, "agent");
            asm volatile("s_waitcnt vmcnt(0)" ::: "memory");
        }
    }
    __syncthreads();
}

template <int HD, int NQT, bool BIAS>
__device__ __forceinline__ void attn_task(const bf16_t* Q, int ldq, const bf16_t* K, int ldk, const bf16_t* Vt, size_t ldv, int nkeys, bf16_t* O, int ldo,
                                          const float* relb, int qpos0, int kpos0, int lane) {
    const int l16 = lane & 15, fq = lane >> 4;
    bf16x8 qf[NQT][HD / 32];
#pragma unroll
    for (int t = 0; t < NQT; ++t)
#pragma unroll
        for (int ds = 0; ds < HD / 32; ++ds) qf[t][ds] = *(const bf16x8*)(Q + (size_t)(16 * t + l16) * ldq + 32 * ds + 8 * fq);
    f32x4 o[NQT][HD / 16]; float mrun[NQT], lsum[NQT];
#pragma unroll
    for (int t = 0; t < NQT; ++t) { mrun[t] = -INFINITY; lsum[t] = 0.f;
#pragma unroll
        for (int dt = 0; dt < HD / 16; ++dt) o[t][dt] = (f32x4){0.f, 0.f, 0.f, 0.f}; }
    float bfar = 0.f; if (BIAS) bfar = relb[256] * LOG2E;
    for (int key0 = 0; key0 < nkeys; key0 += 32) {
        f32x4 s[NQT][2];
#pragma unroll
        for (int t = 0; t < NQT; ++t) { s[t][0] = (f32x4){0.f, 0.f, 0.f, 0.f}; s[t][1] = (f32x4){0.f, 0.f, 0.f, 0.f}; }
        const bf16_t* kp = K + (size_t)(key0 + l16) * ldk + 8 * fq;
#pragma unroll
        for (int ds = 0; ds < HD / 32; ++ds) {
            const bf16x8 k0f = *(const bf16x8*)(kp + 32 * ds), k1f = *(const bf16x8*)(kp + (size_t)16 * ldk + 32 * ds);
#pragma unroll
            for (int t = 0; t < NQT; ++t) { s[t][0] = __builtin_amdgcn_mfma_f32_16x16x32_bf16(k0f, qf[t][ds], s[t][0], 0, 0, 0); s[t][1] = __builtin_amdgcn_mfma_f32_16x16x32_bf16(k1f, qf[t][ds], s[t][1], 0, 0, 0); }
        }
        bf16x8 pf[NQT];
        const bool farstep = BIAS && (qpos0 - (kpos0 + key0 + 31) >= 128);
#pragma unroll
        for (int t = 0; t < NQT; ++t) {
            float x[8];
#pragma unroll
            for (int kb = 0; kb < 2; ++kb)
#pragma unroll
                for (int e = 0; e < 4; ++e) {
                    float bb = 0.f;
                    if (BIAS) { if (farstep) bb = bfar; else { int rel = (qpos0 + 16 * t + l16) - (kpos0 + key0 + 16 * kb + 4 * fq + e); rel = rel < -128 ? -128 : (rel > 128 ? 128 : rel); bb = relb[rel + 128] * LOG2E; } }
                    x[4 * kb + e] = s[t][kb][e] * LOG2E + bb;
                }
            float mt = fmaxf(fmaxf(fmaxf(x[0], x[1]), fmaxf(x[2], x[3])), fmaxf(fmaxf(x[4], x[5]), fmaxf(x[6], x[7])));
            mt = fmaxf(mt, __shfl_xor(mt, 16)); mt = fmaxf(mt, __shfl_xor(mt, 32));
            const float mnew = fmaxf(mrun[t], mt), scl = __builtin_amdgcn_exp2f(mrun[t] - mnew); mrun[t] = mnew;
            float ps = 0.f;
#pragma unroll
            for (int e = 0; e < 8; ++e) { x[e] = __builtin_amdgcn_exp2f(x[e] - mnew); ps += x[e]; }
            lsum[t] = lsum[t] * scl + ps;
#pragma unroll
            for (int dt = 0; dt < HD / 16; ++dt) o[t][dt] = o[t][dt] * scl;
            u32x4 w; w.x = pg8::cvt_pk_bf16(x[0], x[1]); w.y = pg8::cvt_pk_bf16(x[2], x[3]); w.z = pg8::cvt_pk_bf16(x[4], x[5]); w.w = pg8::cvt_pk_bf16(x[6], x[7]);
            pf[t] = __builtin_bit_cast(bf16x8, w);
        }
        const bf16_t* vp = Vt + (size_t)l16 * ldv + key0 + 4 * fq;
#pragma unroll
        for (int dt = 0; dt < HD / 16; ++dt) {
            const u32x2 lo = *(const u32x2*)(vp + (size_t)(16 * dt) * ldv), hi = *(const u32x2*)(vp + (size_t)(16 * dt) * ldv + 16);
            const u32x4 vv = (u32x4){lo.x, lo.y, hi.x, hi.y}; const bf16x8 vf = __builtin_bit_cast(bf16x8, vv);
#pragma unroll
            for (int t = 0; t < NQT; ++t) o[t][dt] = __builtin_amdgcn_mfma_f32_16x16x32_bf16(vf, pf[t], o[t][dt], 0, 0, 0);
        }
    }
#pragma unroll
    for (int t = 0; t < NQT; ++t) {
        float l = lsum[t]; l += __shfl_xor(l, 16); l += __shfl_xor(l, 32); const float inv = 1.0f / l;
        bf16_t* op = O + (size_t)(16 * t + l16) * ldo + 4 * fq;
#pragma unroll
        for (int dt = 0; dt < HD / 16; ++dt) { const f32x4 v = o[t][dt] * inv; u32x2 w; w.x = pg8::cvt_pk_bf16(v[0], v[1]); w.y = pg8::cvt_pk_bf16(v[2], v[3]); *(u32x2*)(op + 16 * dt) = w; }
    }
}
__device__ __forceinline__ void chunk_attn_phase(const bf16_t* QK, const bf16_t* Vt, bf16_t* O, const float* relb) {
    const int tid = tidx(), lane = tid & 63, wave = tid >> 6;
    for (int task = bidx() * 8 + wave; task < 16384; task += gdim() * 8) {
        const int half = task & 1, c = (task >> 1) & 31, h = (task >> 6) & 15, b = task >> 10;
        const int kc0 = c > 8 ? c - 8 : 0;
        const size_t qrow = (size_t)b * SEQ + c * 64 + half * 32, krow = (size_t)b * SEQ + kc0 * 64;
        attn_task<64, 2, true>(QK + qrow * 2048 + h * 64, 2048, QK + krow * 2048 + 1024 + h * 64, 2048, Vt + (size_t)(h * 64) * M + krow, (size_t)M, (c + 1 - kc0) * 64,
                               O + qrow * D + h * 64, D, relb + h * 257, c * 64 + half * 32, kc0 * 64, lane);
    }
}
__device__ __forceinline__ void mem_attn_phase(const bf16_t* Qx, const bf16_t* Km, const bf16_t* Vtm, bf16_t* O) {
    const int tid = tidx(), lane = tid & 63, wave = tid >> 6;
    for (int task = bidx() * 8 + wave; task < 8192; task += gdim() * 8) {
        const int qt = task & 127, mh = (task >> 7) & 3, b = task >> 9;
        const size_t qrow = (size_t)b * SEQ + qt * 16;
        attn_task<256, 1, false>(Qx + qrow * D + mh * 256, D, Km + (size_t)(b * MEMT) * D + mh * 256, D, Vtm + (size_t)(mh * 256) * MM + b * MEMT, (size_t)MM, MEMT,
                                 O + qrow * D + mh * 256, D, nullptr, 0, 0, lane);
    }
}

__device__ __forceinline__ void conv_phase(const bf16_t* UX, bf16_t* XR, const float* cw, const float* cb) {
    const int gt = bidx() * 512 + tidx(), NGT = gdim() * 512;
    for (int idx = gt; idx < M * (DP / 8); idx += NGT) {
        const int m = idx / (DP / 8), c8 = (idx % (DP / 8)) * 8; u32x4 o = (u32x4){0u, 0u, 0u, 0u};
        if (c8 < DR) {
            const int t = m & (SEQ - 1); float acc[8];
#pragma unroll
            for (int e = 0; e < 8; ++e) acc[e] = cb[c8 + e];
#pragma unroll
            for (int k = 0; k < 4; ++k) { if (t - 3 + k >= 0) { const u32x4 u = *(const u32x4*)(UX + (size_t)(m - 3 + k) * DP + c8); const float* w = cw + k * DR + c8;
                    acc[0] += w[0] * bflo(u.x); acc[1] += w[1] * bfhi(u.x); acc[2] += w[2] * bflo(u.y); acc[3] += w[3] * bfhi(u.y);
                    acc[4] += w[4] * bflo(u.z); acc[5] += w[5] * bfhi(u.z); acc[6] += w[6] * bflo(u.w); acc[7] += w[7] * bfhi(u.w); } }
            o.x = pk2(acc[0], acc[1]); o.y = pk2(acc[2], acc[3]); o.z = pk2(acc[4], acc[5]); o.w = pk2(acc[6], acc[7]);
        }
        *(u32x4*)(XR + (size_t)m * DP + c8) = o;
    }
}
__device__ __forceinline__ float nexpm1_(float t) { return (t > -0.05f) ? -(t * (1.0f + t * (0.5f + t * (0.16666667f + t * 0.041666668f)))) : 1.0f - __expf(t); }
__device__ __forceinline__ void unpack8(const u32x4 u, float (&f)[8]) { f[0] = bflo(u.x); f[1] = bfhi(u.x); f[2] = bflo(u.y); f[3] = bfhi(u.y); f[4] = bflo(u.z); f[5] = bfhi(u.z); f[6] = bflo(u.w); f[7] = bfhi(u.w); }
__device__ __forceinline__ void scan_phase(LAS unsigned char* lds, const bf16_t* GATES, const bf16_t* XR, bf16_t* UG, const float* lam) {
    const int tid = tidx(), cq = tid & 3, seg = tid >> 2;
    LAS float* sA = (LAS float*)lds; LAS float* sB = sA + 4096;
    for (int unit = bidx(); unit < NB * 42; unit += gdim()) {
        const int b = unit / 42, c0 = (unit % 42) * 32 + cq * 8;
        float sp[8];
#pragma unroll
        for (int e = 0; e < 8; ++e) sp[e] = 8.0f * softplus_(-lam[c0 + e]);
        const size_t m0 = (size_t)b * SEQ + seg * 16;
        float A[8], B[8];
#pragma unroll
        for (int e = 0; e < 8; ++e) { A[e] = 1.f; B[e] = 0.f; }
#pragma unroll 4
        for (int t = 0; t < 16; ++t) {
            const size_t m = m0 + t; float r[8], ig[8], x[8];
            unpack8(*(const u32x4*)(GATES + m * 3072 + c0), r); unpack8(*(const u32x4*)(GATES + m * 3072 + DP + c0), ig); unpack8(*(const u32x4*)(XR + m * DP + c0), x);
#pragma unroll
            for (int e = 0; e < 8; ++e) { const float la = -sp[e] * r[e], av = __expf(la), bt = sqrtf(nexpm1_(2.0f * la)) * (ig[e] * x[e]); B[e] = av * B[e] + bt; A[e] *= av; }
        }
        { LAS float* pa = sA + seg * 32 + cq * 8; LAS float* pb = sB + seg * 32 + cq * 8;
          *(LAS f32x4*)pa = (f32x4){A[0], A[1], A[2], A[3]}; *(LAS f32x4*)(pa + 4) = (f32x4){A[4], A[5], A[6], A[7]};
          *(LAS f32x4*)pb = (f32x4){B[0], B[1], B[2], B[3]}; *(LAS f32x4*)(pb + 4) = (f32x4){B[4], B[5], B[6], B[7]}; }
        __syncthreads();
        if (tid < 32) { float hh = 0.f;
#pragma unroll 8
            for (int s2 = 0; s2 < 128; ++s2) { const float a = sA[s2 * 32 + tid], bb = sB[s2 * 32 + tid]; sB[s2 * 32 + tid] = hh; hh = a * hh + bb; } }
        __syncthreads();
        float h[8];
        { const LAS float* pb = sB + seg * 32 + cq * 8; const f32x4 h0 = *(const LAS f32x4*)pb, h1 = *(const LAS f32x4*)(pb + 4);
          h[0] = h0.x; h[1] = h0.y; h[2] = h0.z; h[3] = h0.w; h[4] = h1.x; h[5] = h1.y; h[6] = h1.z; h[7] = h1.w; }
        for (int t4 = 0; t4 < 16; t4 += 4) {
            u32x4 R4[4], I4[4], X4[4], U4[4];
#pragma unroll
            for (int q = 0; q < 4; ++q) { const size_t m = m0 + t4 + q; R4[q] = *(const u32x4*)(GATES + m * 3072 + c0); I4[q] = *(const u32x4*)(GATES + m * 3072 + DP + c0); X4[q] = *(const u32x4*)(XR + m * DP + c0); U4[q] = *(const u32x4*)(UG + m * DP + c0); }
#pragma unroll
            for (int q = 0; q < 4; ++q) {
                const size_t m = m0 + t4 + q; float r[8], ig[8], x[8], ug[8];
                unpack8(R4[q], r); unpack8(I4[q], ig); unpack8(X4[q], x); unpack8(U4[q], ug);
#pragma unroll
                for (int e = 0; e < 8; ++e) { const float la = -sp[e] * r[e], av = __expf(la), bt = sqrtf(nexpm1_(2.0f * la)) * (ig[e] * x[e]); h[e] = av * h[e] + bt; ug[e] *= h[e]; }
                u32x4 o; o.x = pk2(ug[0], ug[1]); o.y = pk2(ug[2], ug[3]); o.z = pk2(ug[4], ug[5]); o.w = pk2(ug[6], ug[7]);
                *(u32x4*)(UG + m * DP + c0) = o;
            }
        }
        __syncthreads();
    }
}

__device__ __forceinline__ void prep_phase(const float* H, bf16_t* X, const float* mu, int mode) {
    const int gt = bidx() * 512 + tidx(), NGT = gdim() * 512;
    const int i0 = mode ? 0 : 1, i1 = mode ? 2 : 4, i2 = mode ? 3 : 5;
    for (int idx = gt; idx < M * (D / 8); idx += NGT) {
        const int m = idx >> 7, c8 = (idx & 127) * 8; const int t = m & (SEQ - 1);
        const float* hp = H + (size_t)m * D + c8;
        const f32x4 h0 = *(const f32x4*)hp, h1 = *(const f32x4*)(hp + 4);
        f32x4 p0 = (f32x4){0.f, 0.f, 0.f, 0.f}, p1 = p0;
        if (t > 0) { p0 = *(const f32x4*)(hp - D); p1 = *(const f32x4*)(hp - D + 4); }
        const f32x4 x0 = p0 - h0, x1 = p1 - h1;
#pragma unroll
        for (int q = 0; q < 3; ++q) {
            const int mi = q == 0 ? i0 : (q == 1 ? i1 : i2);
            const f32x4 m0 = *(const f32x4*)(mu + mi * D + c8), m1 = *(const f32x4*)(mu + mi * D + c8 + 4);
            const f32x4 y0 = h0 + x0 * m0, y1 = h1 + x1 * m1;
            u32x4 o; o.x = pk2(y0.x, y0.y); o.y = pk2(y0.z, y0.w); o.z = pk2(y1.x, y1.y); o.w = pk2(y1.z, y1.w);
            bf16_t* dst = mode ? (X + (size_t)q * M * D + (size_t)m * D + c8) : (X + (size_t)m * 3072 + q * D + c8);
            *(u32x4*)dst = o;
        }
    }
}
__device__ __forceinline__ void rwkv_rec_phase(LAS unsigned char* lds, const bf16_t* RKV, const bf16_t* DAG, bf16_t* YG, const float* k_k, const float* k_a, const float* r_k,
                                               const float* lnx_g, const float* lnx_b) {
    LAS float* sAA = (LAS float*)lds; LAS float* sBB = sAA + 1024; LAS float* sW = sAA + 2048; LAS float* sK = sAA + 3072; LAS float* sR = sAA + 4096; LAS float* sV = sAA + 5120; LAS float* sY = sAA + 6144;
    const int tid = tidx(), tt = tid >> 5, jp = tid & 31, ri = tid >> 3, cg8 = tid & 7;
    for (int unit = bidx(); unit < 256; unit += gdim()) {
        const int b = unit >> 4, h = unit & 15, hc = h * 64 + 2 * jp;
        const float kk0 = k_k[hc], kk1 = k_k[hc + 1], ka0 = k_a[hc], ka1 = k_a[hc + 1], rk0 = r_k[hc], rk1 = r_k[hc + 1];
        const float lg0 = lnx_g[hc], lg1 = lnx_g[hc + 1], lb0 = lnx_b[hc], lb1 = lnx_b[hc + 1];
        float st[8];
#pragma unroll
        for (int e = 0; e < 8; ++e) st[e] = 0.f;
        const size_t mbase = (size_t)b * SEQ;
        unsigned pr, pk, pv, pd, pa, pg;
        { const size_t m = mbase + tt; const bf16_t* p = RKV + m * 3072 + hc; const bf16_t* q = DAG + m * 3072 + hc;
          pr = *(const unsigned*)p; pk = *(const unsigned*)(p + 1024); pv = *(const unsigned*)(p + 2048); pd = *(const unsigned*)q; pa = *(const unsigned*)(q + 1024); pg = *(const unsigned*)(q + 2048); }
        for (int blk = 0; blk < SEQ / 16; ++blk) {
            const size_t m = mbase + blk * 16 + tt;
            const float r0 = bflo(pr), r1 = bfhi(pr), k0 = bflo(pk), k1 = bfhi(pk), v0 = bflo(pv), v1 = bfhi(pv);
            const float d0 = bflo(pd), d1 = bfhi(pd), a0 = bflo(pa), a1 = bfhi(pa), g0 = bflo(pg), g1 = bfhi(pg);
            const float q0 = k0 * kk0, q1 = k1 * kk1; float ss = q0 * q0 + q1 * q1;
#pragma unroll
            for (int o = 1; o < 32; o <<= 1) ss += __shfl_xor(ss, o);
            const float inv = 1.0f / fmaxf(sqrtf(ss), 1e-12f);
            const float n0 = q0 * inv, n1 = q1 * inv;
            const float kp0 = k0 * (1.0f + (a0 - 1.0f) * ka0), kp1 = k1 * (1.0f + (a1 - 1.0f) * ka1);
            float bon = r0 * kp0 * rk0 + r1 * kp1 * rk1;
#pragma unroll
            for (int o = 1; o < 32; o <<= 1) bon += __shfl_xor(bon, o);
            const int li = tt * 64 + 2 * jp;
            *(LAS f32x2*)(sAA + li) = (f32x2){-n0, -n1}; *(LAS f32x2*)(sBB + li) = (f32x2){n0 * a0, n1 * a1};
            *(LAS f32x2*)(sW + li) = (f32x2){__expf(d0), __expf(d1)}; *(LAS f32x2*)(sK + li) = (f32x2){kp0, kp1};
            *(LAS f32x2*)(sR + li) = (f32x2){r0, r1}; *(LAS f32x2*)(sV + li) = (f32x2){v0, v1};
            __syncthreads();
            if (blk + 1 < SEQ / 16) { const size_t m2 = m + 16; const bf16_t* p = RKV + m2 * 3072 + hc; const bf16_t* q = DAG + m2 * 3072 + hc;
                pr = *(const unsigned*)p; pk = *(const unsigned*)(p + 1024); pv = *(const unsigned*)(p + 2048); pd = *(const unsigned*)q; pa = *(const unsigned*)(q + 1024); pg = *(const unsigned*)(q + 2048); }
#pragma unroll 2
            for (int t2 = 0; t2 < 16; ++t2) {
                const int lo = t2 * 64 + 8 * cg8;
                const f32x4 aa0 = *(const LAS f32x4*)(sAA + lo), aa1 = *(const LAS f32x4*)(sAA + lo + 4), ww0 = *(const LAS f32x4*)(sW + lo), ww1 = *(const LAS f32x4*)(sW + lo + 4);
                const f32x4 bb0 = *(const LAS f32x4*)(sBB + lo), bb1 = *(const LAS f32x4*)(sBB + lo + 4), kx0 = *(const LAS f32x4*)(sK + lo), kx1 = *(const LAS f32x4*)(sK + lo + 4);
                const f32x4 rr0 = *(const LAS f32x4*)(sR + lo), rr1 = *(const LAS f32x4*)(sR + lo + 4); const float vi = sV[t2 * 64 + ri];
                float sa = (st[0] * aa0.x + st[1] * aa0.y) + (st[2] * aa0.z + st[3] * aa0.w) + (st[4] * aa1.x + st[5] * aa1.y) + (st[6] * aa1.z + st[7] * aa1.w);
                sa += __shfl_xor(sa, 1); sa += __shfl_xor(sa, 2); sa += __shfl_xor(sa, 4);
                st[0] = st[0] * ww0.x + sa * bb0.x + vi * kx0.x; st[1] = st[1] * ww0.y + sa * bb0.y + vi * kx0.y; st[2] = st[2] * ww0.z + sa * bb0.z + vi * kx0.z; st[3] = st[3] * ww0.w + sa * bb0.w + vi * kx0.w;
                st[4] = st[4] * ww1.x + sa * bb1.x + vi * kx1.x; st[5] = st[5] * ww1.y + sa * bb1.y + vi * kx1.y; st[6] = st[6] * ww1.z + sa * bb1.z + vi * kx1.z; st[7] = st[7] * ww1.w + sa * bb1.w + vi * kx1.w;
                float y = (st[0] * rr0.x + st[1] * rr0.y) + (st[2] * rr0.z + st[3] * rr0.w) + (st[4] * rr1.x + st[5] * rr1.y) + (st[6] * rr1.z + st[7] * rr1.w);
                y += __shfl_xor(y, 1); y += __shfl_xor(y, 2); y += __shfl_xor(y, 4);
                if (cg8 == 0) sY[t2 * 64 + ri] = y;
            }
            __syncthreads();
            const f32x2 yy = *(const LAS f32x2*)(sY + li);
            float sm = yy.x + yy.y;
#pragma unroll
            for (int o = 1; o < 32; o <<= 1) sm += __shfl_xor(sm, o);
            const float mean = sm * (1.0f / 64.0f), e0 = yy.x - mean, e1 = yy.y - mean; float vs = e0 * e0 + e1 * e1;
#pragma unroll
            for (int o = 1; o < 32; o <<= 1) vs += __shfl_xor(vs, o);
            const float rs = 1.0f / sqrtf(vs * (1.0f / 64.0f) + 64e-5f);
            const float o0 = ((e0 * rs) * lg0 + lb0 + bon * v0) * g0, o1 = ((e1 * rs) * lg1 + lb1 + bon * v1) * g1;
            *(unsigned*)(YG + m * D + hc) = pk2(o0, o1);
        }
        __syncthreads();
    }
}

#define HAS(x) ((OPMASK >> (x)) & 1u)
enum { OP_PRO, OP_WIN, OP_CONV, OP_GATES, OP_SCAN, OP_RES, OP_LN, OP_PREP, OP_L1, OP_PLAIN, OP_L2, OP_REC, OP_CATT, OP_XATT, OP_MLP1 };

__host__ __device__ __forceinline__ void decode_phase(int pc, int& L, int& s, int& kind, int& j, int& op, int& sub) {
    if (pc < 1) { L = 0; s = -1; } else if (pc < 14) { L = 0; s = pc - 1; } else if (pc < 29) { L = 1; s = pc - 14; } else if (pc < 40) { L = 2; s = pc - 29; } else { L = 3; s = pc - 40; }
    kind = L % 3; j = L / 3; const int mlen = kind == 0 ? 6 : (kind == 1 ? 8 : 4);
    sub = 0;
    if (s < 0) op = OP_PRO;
    else if (s < mlen) {
        if (kind == 0) { op = s == 0 ? OP_WIN : s == 1 ? OP_CONV : s == 2 ? OP_GATES : s == 3 ? OP_SCAN : s == 4 ? OP_RES : OP_LN; }
        else if (kind == 1) { op = s == 0 ? OP_PREP : s == 1 ? OP_L1 : s == 2 ? OP_PREP : s == 3 ? OP_PLAIN : s == 4 ? OP_L2 : s == 5 ? OP_REC : s == 6 ? OP_RES : OP_LN; sub = (s == 2) ? 1 : 0; }
        else { op = s == 0 ? OP_PLAIN : s == 1 ? OP_CATT : s == 2 ? OP_RES : OP_LN; sub = (s == 0) ? 1 : 0; }
    } else {
        const int cs = s - mlen;
        op = cs == 0 ? OP_PLAIN : cs == 1 ? OP_XATT : cs == 2 ? OP_RES : cs == 3 ? OP_LN : cs == 4 ? OP_MLP1 : cs == 5 ? OP_RES : OP_LN;
        sub = cs == 0 ? 2 : cs == 2 ? 1 : cs == 3 ? 1 : cs == 5 ? 2 : cs == 6 ? 2 : 0;
    }
}
template <unsigned OPMASK> __global__ void __launch_bounds__(512, 2) fwd(Args a0) {
    extern __shared__ __attribute__((aligned(16))) unsigned char lds_raw[];
    LAS unsigned char* lds = (LAS unsigned char*)lds_raw;
    cg::grid_group grid = cg::this_grid();
    const int plo = a0.lo, phi = a0.hi;
    if (tidx() == 0) {
        LAS unsigned long long* tab = (LAS unsigned long long*)(lds + TAB_OFF);
#pragma unroll
        for (int i = 0; i < 37; ++i) tab[i] = (unsigned long long)a0.in[i];
        tab[37] = (unsigned long long)a0.out; tab[38] = (unsigned long long)a0.ws;
    }
    volatile LAS unsigned* bst = (volatile LAS unsigned*)(lds + TAB_OFF + 512);
    if (tidx() == 0) { bst[0] = 0u; bst[1] = 0u; }
    __syncthreads();
    XcdBarrier bar; bar.bar = (unsigned*)a0.ws; bar.x = 0; bar.st = bst;
    if (phi - plo > 1) bar = xcd_barrier_post((unsigned*)a0.ws, bst);
    for (int pc = plo; pc < phi; ++pc) {
        if (pc > plo) { if (pc == plo + 1) grid.sync(); else xcd_barrier(bar); }
        unsigned char* ws = WSP; float* H = OUTP;
        bf16_t* WC = (bf16_t*)(ws + WS_WC); bf16_t* MEMB = (bf16_t*)(ws + WS_MEMB); bf16_t* WM = (bf16_t*)(ws + WS_WM); bf16_t* HB = (bf16_t*)(ws + WS_HB);
        unsigned char* S = ws + WS_S;
        int L, s, kind, j, op, sub; decode_phase(pc, L, s, kind, j, op, sub);

        if (HAS(OP_PRO) && op == OP_PRO) {
            const int gt = bidx() * 512 + tidx(), NGT = gdim() * 512;
            const float* x = IN(0); const float* mem = IN(1);
            for (int idx = gt; idx < M * D / 8; idx += NGT) { const f32x4 v0 = *(const f32x4*)(x + (size_t)idx * 8), v1 = *(const f32x4*)(x + (size_t)idx * 8 + 4);
                *(f32x4*)(H + (size_t)idx * 8) = v0; *(f32x4*)(H + (size_t)idx * 8 + 4) = v1;
                u32x4 o; o.x = pk2(v0.x, v0.y); o.y = pk2(v0.z, v0.w); o.z = pk2(v1.x, v1.y); o.w = pk2(v1.z, v1.w); *(u32x4*)(HB + (size_t)idx * 8) = o; }
            for (int idx = gt; idx < MM * D / 8; idx += NGT) { const f32x4 v0 = *(const f32x4*)(mem + (size_t)idx * 8), v1 = *(const f32x4*)(mem + (size_t)idx * 8 + 4);
                u32x4 o; o.x = pk2(v0.x, v0.y); o.y = pk2(v0.z, v0.w); o.z = pk2(v1.x, v1.y); o.w = pk2(v1.z, v1.w); *(u32x4*)(MEMB + (size_t)idx * 8) = o; }
            convert_layer(0, lds);
        }
        else if (HAS(OP_WIN) && op == OP_WIN) {
            EpiT<1> E{{(bf16_t*)S, (bf16_t*)(S + 192 * MiB), DP, nullptr, nullptr, 1.f, 0}};
            run_gemm(lds, HB, WM, M, 2 * DP, D, 1 << 30, 0, E);
        }
        else if (HAS(OP_CONV) && op == OP_CONV) { conv_phase((const bf16_t*)(S + 192 * MiB), (bf16_t*)(S + 96 * MiB), IN(5) + (size_t)j * 4 * DR, IN(6) + (size_t)j * DR); }
        else if (HAS(OP_GATES) && op == OP_GATES) {
            EpiT<2> E{{(bf16_t*)(S + 192 * MiB), nullptr, 2 * DP, IN(8) + (size_t)j * 2 * DR, nullptr, 1.f, 0}};
            run_gemm(lds, (const bf16_t*)(S + 96 * MiB), WM + 6 * MiB / 2, M, 2 * DP, DP, 1 << 30, 0, E, 1);
        }
        else if (HAS(OP_SCAN) && op == OP_SCAN) { scan_phase(lds, (const bf16_t*)(S + 192 * MiB), (const bf16_t*)(S + 96 * MiB), (bf16_t*)S, IN(9) + (size_t)j * DR); }
        else if (HAS(OP_RES) && op == OP_RES) {
            const bf16_t* A; const bf16_t* Bt; int K;
            if (sub == 0) {
                if (kind == 0) { A = (const bf16_t*)S; Bt = WM + 15 * MiB / 2; K = DP; }
                else if (kind == 1) { A = HB; Bt = WM + 10 * MiB / 2; K = D; }
                else { A = (const bf16_t*)(S + 192 * MiB); Bt = WM + 6 * MiB / 2; K = D; }
            } else if (sub == 1) { A = (const bf16_t*)(S + 64 * MiB); Bt = WC + WC_O / 2; K = D; }
            else { A = (const bf16_t*)S; Bt = WC + WC_W2 / 2; K = FF; }
            EpiRes E{H};
            run_gemm(lds, A, Bt, M, D, K, 1 << 30, 0, E);
        }
        else if (HAS(OP_LN) && op == OP_LN) {
            ln_phase(H, HB, IN(2) + (size_t)(L * 3 + sub) * D, IN(3) + (size_t)(L * 3 + sub) * D);
            if (sub == 2 && L < 3) convert_layer(L + 1, lds);
        }
        else if (HAS(OP_PREP) && op == OP_PREP) { prep_phase(H, (bf16_t*)S, IN(11) + (size_t)j * 6 * D, sub); }
        else if (HAS(OP_L1) && op == OP_L1) {
            EpiT<3> E{{HB, nullptr, 256, nullptr, nullptr, 1.f, 0}};
            run_gemm(lds, (const bf16_t*)S, WM + 6 * MiB / 2, M, 256, 3 * D, 1 << 30, 0, E);
        }
        else if (HAS(OP_L2) && op == OP_L2) {
            EpiT<4> E{{(bf16_t*)S, nullptr, 3 * D, IN(15) + (size_t)j * D, IN(18) + (size_t)j * D, 1.f, 0}};
            run_gemm(lds, HB, WM + 8 * MiB / 2, M, 3 * D, 256, 1 << 30, 0, E);
        }
        else if (HAS(OP_REC) && op == OP_REC) { rwkv_rec_phase(lds, (const bf16_t*)(S + 192 * MiB), (const bf16_t*)S, HB, IN(23) + (size_t)j * D, IN(24) + (size_t)j * D, IN(25) + (size_t)j * D, IN(26) + (size_t)j * D, IN(27) + (size_t)j * D); }
        else if (HAS(OP_PLAIN) && op == OP_PLAIN) {
            const int ng = sub == 0 ? 1 : (sub == 1 ? 2 : 3);
            for (int g = 0; g < ng; ++g) {
                const bf16_t* A; const bf16_t* Bt; int M_, N_, asplit = 1 << 30; size_t astride = 0; EpiP P{nullptr, nullptr, 0, nullptr, nullptr, 1.f, 0};
                if (sub == 0) { A = (const bf16_t*)S; Bt = WM; M_ = M; N_ = 3 * D; asplit = 4; astride = (size_t)M * D * 2; P.O = (bf16_t*)(S + 192 * MiB); P.ldc = 3 * D; }
                else if (sub == 1) {
                    if (g == 0) { A = HB; Bt = WM; M_ = M; N_ = 2 * D; P.O = (bf16_t*)S; P.ldc = 2 * D; P.scale = 0.125f; P.scale_cols = D; }
                    else { A = WM + 4 * MiB / 2; Bt = HB; M_ = D; N_ = M; P.O = (bf16_t*)(S + 128 * MiB); P.ldc = M; }
                } else {
                    if (g == 0) { A = HB; Bt = WC + WC_Q / 2; M_ = M; N_ = D; P.O = (bf16_t*)S; P.ldc = D; P.scale = 0.0625f; P.scale_cols = D; }
                    else if (g == 1) { A = MEMB; Bt = WC + WC_K / 2; M_ = MM; N_ = D; P.O = WM; P.ldc = D; }
                    else { A = WC + WC_V / 2; Bt = MEMB; M_ = D; N_ = MM; P.O = WM + 8 * MiB / 2; P.ldc = MM; }
                }
                EpiT<0> E{P};
                run_gemm(lds, A, Bt, M_, N_, D, asplit, astride, E);
            }
        }
        else if (HAS(OP_CATT) && op == OP_CATT) { chunk_attn_phase((const bf16_t*)S, (const bf16_t*)(S + 128 * MiB), (bf16_t*)(S + 192 * MiB), IN(30) + (size_t)j * 16 * 257); }
        else if (HAS(OP_XATT) && op == OP_XATT) { mem_attn_phase((const bf16_t*)S, WM, WM + 8 * MiB / 2, (bf16_t*)(S + 64 * MiB)); }
        else if (HAS(OP_MLP1) && op == OP_MLP1) {
            EpiT<5> E{{(bf16_t*)S, nullptr, FF, nullptr, nullptr, 1.f, 0}};
            run_gemm(lds, HB, WC + WC_W1 / 2, M, FF, D, 1 << 30, 0, E);
        }
    }
}

#ifndef MK_COOP
#define MK_COOP 0
#endif
template <unsigned MASK> static void launch_one(const Args& a, hipStream_t stream) {
    static bool attr = false;
    if (!attr) { attr = true; if (hipFuncSetAttribute((const void*)fwd<MASK>, hipFuncAttributeMaxDynamicSharedMemorySize, LDS_BYTES) != hipSuccess) fprintf(stderr, "kernel_launch: hipFuncSetAttribute failed\n"); }
    hipLaunchKernelGGL(fwd<MASK>, dim3(256), dim3(512), LDS_BYTES, stream, a);
}
extern "C" void kernel_launch(void* const* d_in, const int* in_sizes, int n_in, void* d_out, int out_size, void* d_ws, size_t ws_size, hipStream_t stream) {
    static int ready = 0;
    if (ready == 0) {
        ready = 1;
        if (n_in != 37 || out_size != M * D || ws_size < WS_END) { fprintf(stderr, "kernel_launch: unexpected shapes: n_in %d out %d ws %zu (need %zu)\n", n_in, out_size, ws_size, (size_t)WS_END); ready = -1; }
    }
    if (ready < 0) return;
    Args a{};
    for (int i = 0; i < 37; ++i) a.in[i] = (const float*)d_in[i];
    a.out = (float*)d_out; a.ws = (unsigned char*)d_ws;
#if MK_COOP
    static bool attr = false;
    if (!attr) { attr = true; if (hipFuncSetAttribute((const void*)fwd<0xFFFFFFFFu>, hipFuncAttributeMaxDynamicSharedMemorySize, LDS_BYTES) != hipSuccess) fprintf(stderr, "kernel_launch: hipFuncSetAttribute failed\n"); }
    a.lo = 0; a.hi = NPHASE;
    if (hipMemsetAsync(d_ws, 0, 16384, stream) != hipSuccess) fprintf(stderr, "kernel_launch: memset of barrier words failed\n");
    void* args[] = {&a};
    hipError_t e = hipLaunchCooperativeKernel((const void*)fwd<0xFFFFFFFFu>, dim3(256), dim3(512), args, LDS_BYTES, stream);
    if (e != hipSuccess) fprintf(stderr, "kernel_launch: cooperative launch failed: %s\n", hipGetErrorString(e));
#else
    for (int pc = 0; pc < NPHASE; ++pc) {
        a.lo = pc; a.hi = pc + 1;
        int L, s, kind, j, op, sub; decode_phase(pc, L, s, kind, j, op, sub);
        switch (op) {
            case OP_PRO: launch_one<1u << OP_PRO>(a, stream); break;
            case OP_WIN: launch_one<1u << OP_WIN>(a, stream); break;
            case OP_CONV: launch_one<1u << OP_CONV>(a, stream); break;
            case OP_GATES: launch_one<1u << OP_GATES>(a, stream); break;
            case OP_SCAN: launch_one<1u << OP_SCAN>(a, stream); break;
            case OP_RES: launch_one<1u << OP_RES>(a, stream); break;
            case OP_LN: launch_one<1u << OP_LN>(a, stream); break;
            case OP_PREP: launch_one<1u << OP_PREP>(a, stream); break;
            case OP_L1: launch_one<1u << OP_L1>(a, stream); break;
            case OP_PLAIN: launch_one<1u << OP_PLAIN>(a, stream); break;
            case OP_L2: launch_one<1u << OP_L2>(a, stream); break;
            case OP_REC: launch_one<1u << OP_REC>(a, stream); break;
            case OP_CATT: launch_one<1u << OP_CATT>(a, stream); break;
            case OP_XATT: launch_one<1u << OP_XATT>(a, stream); break;
            default: launch_one<1u << OP_MLP1>(a, stream); break;
        }
    }
#endif
}
```

```cpp
#include <hip/hip_runtime.h>
#include <hip/hip_cooperative_groups.h>
#include <cstdio>
#include <cstdint>
namespace cg = cooperative_groups;
__device__ __forceinline__ int tidx() { int t = (int)threadIdx.x; asm volatile("" : "+v"(t)); return t; }
__device__ __forceinline__ int bidx() { int t = (int)blockIdx.x; asm volatile("" : "+s"(t)); return t; }
__device__ __forceinline__ int gdim() { int t = (int)gridDim.x; asm volatile("" : "+s"(t)); return t; }
#define MK_COOP 1
namespace pg8 {
#define PG8_LAS __attribute__((address_space(3)))
typedef unsigned short bf16_t;
typedef short bf16x8 __attribute__((ext_vector_type(8)));
typedef float f32x4 __attribute__((ext_vector_type(4)));
typedef unsigned u32x4 __attribute__((ext_vector_type(4)));
constexpr int BM = 256, BK = 64, HALF = 128, HTB = HALF * BK * 2  , STAGE_BYTES = 8 * HTB, NXCD = 8, WGM = 8;

__host__ __device__ __forceinline__ int lds_byte(int r, int c) { const int st = (r >> 4) * 2 + (c >> 5), rr = r & 15, cc = c & 31, ob = rr * 64 + cc * 2; return st * 1024 + (ob ^ (((ob >> 9) & 1) << 5)); }
__host__ __device__ __forceinline__ void stage_rc(int b, int& R, int& C) { const int st = b / 1024, sb = b % 1024, swz = sb ^ (((sb >> 9) & 1) << 5); R = (st >> 1) * 16 + swz / 64; C = (st & 1) * 32 + (swz % 64) / 2; }
__host__ __device__ __forceinline__ int perm32(int rho) { const int n = rho >> 4, i = rho & 15; return 8 * (i >> 2) + 4 * n + (i & 3); }

struct Unit { int pm, pn, k0, nt; };
struct Gemm { const bf16_t* A; const bf16_t* Bt; int M, N, K; int asplit; size_t astride; };

struct StaticOrder {
    int nM, nN, nwg, G, c, kwin, ntfull;
    __host__ __device__ void init(int M, int N, int G_, int c_) { nM = M / BM; nN = N / BM; nwg = nM * nN; G = G_; c = c_; }
    __host__ __device__ bool next(int i, Unit& u) const {
        const long L = (long)i * G + c; if (L >= nwg) return false;
        int wgid = (int)L; { const int q = nwg / NXCD, r = nwg % NXCD, xcd = wgid % NXCD, off = wgid / NXCD; wgid = (xcd < r ? xcd * (q + 1) : r * (q + 1) + (xcd - r) * q) + off; }
        const int nig = WGM * nN, gid = wgid / nig, fm = gid * WGM, gsz = (nM - fm) < WGM ? (nM - fm) : WGM;
        u.pm = fm + ((wgid % nig) % gsz); u.pn = (wgid % nig) / gsz; u.k0 = 0; u.nt = ntfull;
        if (kwin == 1) { const int p = u.pn % 6, clo = 256 * p, chi = (clo + 255 < 1343) ? clo + 255 : 1343; const int klo = 84 * (clo / 84), khi = 84 * (chi / 84 + 1);
            int tlo = klo / 64, thi = (khi + 63) / 64; if ((thi - tlo) & 1) { if (thi < ntfull) ++thi; else --tlo; } u.k0 = tlo; u.nt = thi - tlo; }
        return true;
    }
    __device__ __forceinline__ void a_ready(const Unit&) const {}
    __device__ __forceinline__ void done(const Unit&) const {}
};

__device__ __forceinline__ unsigned cvt_pk_bf16(float lo, float hi) { unsigned r; asm volatile("v_cvt_pk_bf16_f32 %0, %1, %2" : "=v"(r) : "v"(lo), "v"(hi)); return r; }
typedef float f32x2 __attribute__((ext_vector_type(2)));
template <class Epi, class Sched, bool ALIGN_EPI = false, bool SP2 = false>
__device__ __forceinline__ void gemm_phase(PG8_LAS unsigned char* lds, const Gemm g, const Sched& S, const Epi& E) {
    const int tid = tidx(), wid = __builtin_amdgcn_readfirstlane(tid >> 6), lane = tid & 63, wr = wid >> 2, wc = wid & 3, fr = lane & 15, fq = lane >> 4;
    const int K = g.K, nt = K / BK;
    unsigned voffA[2], voffB[2];
#pragma unroll
    for (int i = 0; i < 2; ++i) { int R, C; stage_rc(tid * 16 + i * 8192, R, C); const int Rb = Epi::PERM ? ((R & ~31) + perm32(R & 31)) : R;
        voffA[i] = (unsigned)(R * K + C) * 2u; voffB[i] = (unsigned)(Rb * K + C) * 2u; }
    const size_t kstep = (size_t)(BK * 2);
    const size_t hstep = (size_t)HALF * K * 2;
    const size_t tstep = 2 * hstep;
    const unsigned ldsw = (unsigned)wid * 1024u;
    const int aoff = lds_byte(wr * 64 + fr, fq * 8), boff = lds_byte(wc * 32 + fr, fq * 8);
#define PG8_SA(b, h) (((b) * 2 + (h)) * HTB)
#define PG8_SB(b, h) ((4 + (b) * 2 + (h)) * HTB)
#define PG8_STAGE(bufoff, gbase, voff) do { _Pragma("unroll") for (int _i = 0; _i < 2; ++_i) \
        __builtin_amdgcn_global_load_lds((const unsigned*)((const char*)(gbase) + (voff)[_i]), (PG8_LAS unsigned*)(lds + (bufoff) + ldsw + _i * 8192), 16, 0, 0); } while (0)
#define PG8_LDA(dst, b, h) do { _Pragma("unroll") for (int m = 0; m < 4; ++m) _Pragma("unroll") for (int k = 0; k < 2; ++k) dst[m][k] = *(const PG8_LAS bf16x8*)(lds + PG8_SA(b, h) + aoff + m * 2048 + k * 1024); } while (0)
#define PG8_LDB(dst, b, h) do { _Pragma("unroll") for (int n = 0; n < 2; ++n) _Pragma("unroll") for (int k = 0; k < 2; ++k) dst[n][k] = *(const PG8_LAS bf16x8*)(lds + PG8_SB(b, h) + boff + n * 2048 + k * 1024); } while (0)
#define PG8_MMA(ai, bj, At, Bt) do { __builtin_amdgcn_s_setprio(1); _Pragma("unroll") for (int m = 0; m < 4; ++m) _Pragma("unroll") for (int n = 0; n < 2; ++n) _Pragma("unroll") for (int k = 0; k < 2; ++k) \
        acc[ai][bj][m][n] = __builtin_amdgcn_mfma_f32_16x16x32_bf16(Bt[n][k], At[m][k], acc[ai][bj][m][n], 0, 0, 0); __builtin_amdgcn_s_setprio(0); } while (0)
#define PG8_WAIT_V(n) asm volatile("s_waitcnt vmcnt(" #n ")" ::: "memory")
#define PG8_WAIT_L(n) asm volatile("s_waitcnt lgkmcnt(" #n ")" ::: "memory")
#define PG8_BAR __builtin_amdgcn_s_barrier()
#define PG8_SCHED __builtin_amdgcn_sched_barrier(0)
    Unit cur, nxt; int ui = 0;
    if (!S.next(0, cur)) return;
    f32x4 acc[2][2][4][2];
#pragma unroll
    for (int a = 0; a < 2; ++a)
#pragma unroll
        for (int b = 0; b < 2; ++b)
#pragma unroll
            for (int m = 0; m < 4; ++m)
#pragma unroll
                for (int n = 0; n < 2; ++n) acc[a][b][m][n] = (f32x4){0.f, 0.f, 0.f, 0.f};
    bf16x8 At[4][2], B0[2][2], B1[2][2];
    const char* cA = (const char*)g.A + (size_t)(cur.pn / g.asplit) * g.astride + (size_t)cur.pm * tstep + (size_t)cur.k0 * kstep; const char* cB = (const char*)g.Bt + (size_t)cur.pn * tstep + (size_t)cur.k0 * kstep;
    S.a_ready(cur);
    if constexpr (SP2) {
        PG8_STAGE(PG8_SB(0, 0), cB, voffB); PG8_STAGE(PG8_SB(0, 1), cB + hstep, voffB); PG8_STAGE(PG8_SA(0, 0), cA, voffA); PG8_STAGE(PG8_SA(0, 1), cA + hstep, voffA);
        if (wr == 1) PG8_BAR;
        PG8_WAIT_V(2); PG8_BAR;
        PG8_STAGE(PG8_SB(1, 0), cB + kstep, voffB); PG8_STAGE(PG8_SA(1, 0), cA + kstep, voffA); PG8_STAGE(PG8_SB(1, 1), cB + hstep + kstep, voffB);
        PG8_WAIT_V(6); PG8_BAR;
    } else {
        PG8_STAGE(PG8_SB(0, 0), cB, voffB); PG8_STAGE(PG8_SA(0, 0), cA, voffA); PG8_STAGE(PG8_SB(0, 1), cB + hstep, voffB); PG8_STAGE(PG8_SA(0, 1), cA + hstep, voffA);
        if (wr == 1) PG8_BAR;
        PG8_WAIT_V(4); PG8_BAR;
        PG8_STAGE(PG8_SB(1, 0), cB + kstep, voffB); PG8_STAGE(PG8_SA(1, 0), cA + kstep, voffA); PG8_STAGE(PG8_SB(1, 1), cB + hstep + kstep, voffB);
        PG8_WAIT_V(6); PG8_BAR;
    }
    for (;;) {
        const bool has_next = S.next(ui + 1, nxt);
        const char* nA = has_next ? (const char*)g.A + (size_t)(nxt.pn / g.asplit) * g.astride + (size_t)nxt.pm * tstep + (size_t)nxt.k0 * kstep : cA; const char* nB = has_next ? (const char*)g.Bt + (size_t)nxt.pn * tstep + (size_t)nxt.k0 * kstep : cB;
        const int unt = cur.nt;
        for (int t = 0; t < unt; t += 2) {
            const bool last = (t == unt - 2);
            const char* a1 = cA + (size_t)(t + 1) * kstep;
            const char* a2 = last ? nA : cA + (size_t)(t + 2) * kstep; const char* b2 = last ? nB : cB + (size_t)(t + 2) * kstep;
            const char* a3 = a2 + kstep; const char* b3 = b2 + kstep;
            if (last && has_next) S.a_ready(nxt);
            if constexpr (SP2) {
            PG8_LDB(B0, 0, 0); PG8_LDB(B1, 0, 1); PG8_SCHED; PG8_LDA(At, 0, 0); PG8_STAGE(PG8_SA(1, 1), a1 + hstep, voffA);
            PG8_WAIT_V(8); PG8_WAIT_L(0); PG8_BAR; PG8_MMA(0, 0, At, B0); PG8_MMA(0, 1, At, B1); PG8_BAR; PG8_SCHED;
            PG8_LDA(At, 0, 1); PG8_STAGE(PG8_SB(0, 0), b2, voffB); PG8_STAGE(PG8_SB(0, 1), b2 + hstep, voffB); PG8_STAGE(PG8_SA(0, 0), a2, voffA);
            PG8_WAIT_V(8); PG8_WAIT_L(0); PG8_BAR; PG8_MMA(1, 0, At, B0); PG8_MMA(1, 1, At, B1); PG8_BAR; PG8_SCHED;
            PG8_LDB(B0, 1, 0); PG8_LDB(B1, 1, 1); PG8_SCHED; PG8_LDA(At, 1, 0); PG8_STAGE(PG8_SA(0, 1), a2 + hstep, voffA);
            PG8_WAIT_V(8); PG8_WAIT_L(0); PG8_BAR; PG8_MMA(0, 0, At, B0); PG8_MMA(0, 1, At, B1); PG8_BAR; PG8_SCHED;
            PG8_LDA(At, 1, 1); PG8_STAGE(PG8_SB(1, 0), b3, voffB); PG8_STAGE(PG8_SB(1, 1), b3 + hstep, voffB); PG8_STAGE(PG8_SA(1, 0), a3, voffA);
            PG8_WAIT_V(8); PG8_WAIT_L(0); PG8_BAR; PG8_MMA(1, 0, At, B0); PG8_MMA(1, 1, At, B1); PG8_BAR; PG8_SCHED;
            } else {
            PG8_LDB(B0, 0, 0); PG8_SCHED; PG8_LDA(At, 0, 0); PG8_STAGE(PG8_SA(1, 1), a1 + hstep, voffA);
            PG8_WAIT_L(8); PG8_BAR; PG8_WAIT_L(0); PG8_MMA(0, 0, At, B0); PG8_BAR; PG8_SCHED;
            PG8_LDB(B1, 0, 1); PG8_STAGE(PG8_SB(0, 0), b2, voffB);
            PG8_BAR; PG8_WAIT_L(0); PG8_MMA(0, 1, At, B1); PG8_BAR;
            PG8_LDA(At, 0, 1); PG8_STAGE(PG8_SA(0, 0), a2, voffA);
            PG8_BAR; PG8_WAIT_L(0); PG8_MMA(1, 0, At, B0); PG8_BAR; PG8_SCHED;
            PG8_STAGE(PG8_SB(0, 1), b2 + hstep, voffB);
            PG8_WAIT_V(6); PG8_BAR; PG8_MMA(1, 1, At, B1); PG8_BAR;
            PG8_LDB(B0, 1, 0); PG8_SCHED; PG8_LDA(At, 1, 0); PG8_STAGE(PG8_SA(0, 1), a2 + hstep, voffA);
            PG8_WAIT_L(8); PG8_BAR; PG8_WAIT_L(0); PG8_MMA(0, 0, At, B0); PG8_BAR; PG8_SCHED;
            PG8_LDB(B1, 1, 1); PG8_STAGE(PG8_SB(1, 0), b3, voffB);
            PG8_BAR; PG8_WAIT_L(0); PG8_MMA(0, 1, At, B1); PG8_BAR;
            PG8_LDA(At, 1, 1); PG8_STAGE(PG8_SA(1, 0), a3, voffA);
            PG8_BAR; PG8_WAIT_L(0); PG8_MMA(1, 0, At, B0); PG8_BAR; PG8_SCHED;
            PG8_STAGE(PG8_SB(1, 1), b3 + hstep, voffB);
            PG8_WAIT_V(6); PG8_BAR; PG8_MMA(1, 1, At, B1); PG8_BAR;
            }
        }
        if constexpr (ALIGN_EPI) { if (wr == 0) PG8_BAR; }
        if constexpr (!Epi::AFTER_DRAIN) { E(acc, cur, wr, wc, fr, fq); S.done(cur); }
        if (!has_next) break;
#pragma unroll
        for (int a = 0; a < 2; ++a)
#pragma unroll
            for (int b = 0; b < 2; ++b)
#pragma unroll
                for (int m = 0; m < 4; ++m)
#pragma unroll
                    for (int n = 0; n < 2; ++n) acc[a][b][m][n] = (f32x4){0.f, 0.f, 0.f, 0.f};
        cur = nxt; cA = nA; cB = nB; ++ui;
        if constexpr (ALIGN_EPI) { if (wr == 1) PG8_BAR; }
    }
    PG8_WAIT_V(0);
    if constexpr (!ALIGN_EPI) { if (wr == 0) PG8_BAR; }
    PG8_BAR;
    if constexpr (Epi::AFTER_DRAIN) { E.fused(acc, cur, wr, wc, fr, fq, lds, wid, lane); S.done(cur); }
#undef PG8_SA
#undef PG8_SB
#undef PG8_STAGE
#undef PG8_LDA
#undef PG8_LDB
#undef PG8_MMA
#undef PG8_WAIT_V
#undef PG8_WAIT_L
#undef PG8_BAR
#undef PG8_SCHED
}
}

using pg8::bf16_t; using pg8::f32x4; using pg8::bf16x8; using pg8::u32x4;
#define LAS __attribute__((address_space(3)))
typedef unsigned u32x2 __attribute__((ext_vector_type(2)));
typedef float f32x2 __attribute__((ext_vector_type(2)));

constexpr int M = 32768, D = 1024, SEQ = 2048, NB = 16, DR = 1344, DP = 1536, FF = 4096, MEMT = 256, MM = NB * MEMT;
constexpr float ALPHA = 1.6817928305074290f, LN_EPS = 1e-5f, LOG2E = 1.4426950408889634f;
constexpr size_t MiB = 1u << 20;
constexpr size_t WS_WC = 1 * MiB, WS_MEMB = 25 * MiB, WS_WM = 33 * MiB, WS_HB = 53 * MiB, WS_S = 117 * MiB, WS_END = 501 * MiB;
constexpr size_t WC_Q = 0, WC_K = 2 * MiB, WC_V = 4 * MiB, WC_O = 6 * MiB, WC_W1 = 8 * MiB, WC_W2 = 16 * MiB;
constexpr int LDS_BYTES = 147456;
constexpr int NPHASE = 53;

__device__ __forceinline__ unsigned f2bf(float f) { unsigned u = __builtin_bit_cast(unsigned, f); return (u + 0x7fffu + ((u >> 16) & 1u)) >> 16; }
__device__ __forceinline__ unsigned pk2(float lo, float hi) { return f2bf(lo) | (f2bf(hi) << 16); }
__device__ __forceinline__ float bflo(unsigned u) { return __uint_as_float(u << 16); }
__device__ __forceinline__ float bfhi(unsigned u) { return __uint_as_float(u & 0xffff0000u); }
__device__ __forceinline__ float sigmoid_(float x) { return 1.0f / (1.0f + __expf(-x)); }
__device__ __forceinline__ float softplus_(float x) { return fmaxf(x, 0.f) + __logf(1.0f + __expf(-fabsf(x))); }
__device__ __forceinline__ float tanh_(float x) { return 1.0f - 2.0f / (1.0f + __expf(2.0f * x)); }
__device__ __forceinline__ float gelu_tanh_(float x) { return 0.5f * x * (1.0f + tanh_(0.7978845608028654f * (x + 0.044715f * x * x * x))); }

struct EpiP { bf16_t* O; bf16_t* O2; int ldc; const float* p0; const float* p1; float scale; int scale_cols; };
template <int MODE> struct EpiT {
    static constexpr bool PERM = true, AFTER_DRAIN = false; EpiP P;
    __device__ __forceinline__ void operator()(const f32x4 (&acc)[2][2][4][2], const pg8::Unit& u, int wr, int wc, int fr, int fq) const {
        const int row0 = u.pm * 256 + wr * 64 + fr;
#pragma unroll
        for (int bj = 0; bj < 2; ++bj) {
            const int col = u.pn * 256 + bj * 128 + wc * 32 + 8 * fq;
            float bias[8];
#pragma unroll
            for (int e = 0; e < 8; ++e) bias[e] = 0.f;
            bf16_t* base = P.O; int ocol = col; float sc = 1.f;
            if (MODE == 0) { sc = (col < P.scale_cols) ? P.scale : 1.f; }
            if (MODE == 1) { if (col >= DP) { base = P.O2; ocol = col - DP; } }
            if (MODE == 2) { const int g = col / DP, cc = col - g * DP; if (cc < DR) {
#pragma unroll
                    for (int e = 0; e < 8; ++e) bias[e] = P.p0[g * DR + cc + e]; } }
            if (MODE == 4) { if (col < 2048) { const float* bp = (col < 1024) ? (P.p0 + col) : (P.p1 + (col - 1024));
#pragma unroll
                    for (int e = 0; e < 8; ++e) bias[e] = bp[e]; } }
#pragma unroll
            for (int ai = 0; ai < 2; ++ai)
#pragma unroll
                for (int m = 0; m < 4; ++m) {
                    const int row = row0 + ai * 128 + m * 16;
                    float v[8];
#pragma unroll
                    for (int e = 0; e < 4; ++e) { v[e] = acc[ai][bj][m][0][e]; v[4 + e] = acc[ai][bj][m][1][e]; }
#pragma unroll
                    for (int e = 0; e < 8; ++e) {
                        float x = v[e] + bias[e];
                        if (MODE == 0) x *= sc;
                        if (MODE == 1) { if (col < DP) x = gelu_tanh_(x); }
                        if (MODE == 2) x = sigmoid_(x);
                        if (MODE == 3) { if (col < 64) x = tanh_(x); else if (col >= 128) x = sigmoid_(x); }
                        if (MODE == 4) { if (col < 1024) { const float wl = -softplus_(-x) - 0.5f; x = -__expf(wl); } else if (col < 2048) x = sigmoid_(x); }
                        if (MODE == 5) { x = fmaxf(x, 0.f); x = x * x; }
                        v[e] = x;
                    }
                    u32x4 w; w.x = pg8::cvt_pk_bf16(v[0], v[1]); w.y = pg8::cvt_pk_bf16(v[2], v[3]); w.z = pg8::cvt_pk_bf16(v[4], v[5]); w.w = pg8::cvt_pk_bf16(v[6], v[7]);
                    *(u32x4*)(base + (size_t)row * P.ldc + ocol) = w;
                    asm volatile("" ::: "memory");
                }
        }
    }
};
struct EpiRes {
    static constexpr bool PERM = true, AFTER_DRAIN = false; float* out;
    __device__ __forceinline__ void operator()(const f32x4 (&acc)[2][2][4][2], const pg8::Unit& u, int wr, int wc, int fr, int fq) const {
        const int row0 = u.pm * 256 + wr * 64 + fr;
#pragma unroll
        for (int bj = 0; bj < 2; ++bj) {
            const int col = u.pn * 256 + bj * 128 + wc * 32 + 8 * fq;
#pragma unroll
            for (int ai = 0; ai < 2; ++ai)
#pragma unroll
                for (int m = 0; m < 4; ++m) {
                    float* p = out + (size_t)(row0 + ai * 128 + m * 16) * D + col;
                    f32x4 b0 = *(const f32x4*)p, b1 = *(const f32x4*)(p + 4);
                    b0 = b0 * ALPHA + acc[ai][bj][m][0]; b1 = b1 * ALPHA + acc[ai][bj][m][1];
                    *(f32x4*)p = b0; *(f32x4*)(p + 4) = b1;
                    if (m & 1) asm volatile("" ::: "memory");
                }
        }
    }
};

template <class Epi> __device__ __forceinline__ void run_gemm(LAS unsigned char* lds, const bf16_t* A, const bf16_t* Bt, int M_, int N_, int K_, int asplit, size_t astride, const Epi& E, int kwin = 0) {
    asm volatile("" : "+s"(K_));
    pg8::Gemm g{A, Bt, M_, N_, K_, asplit, astride}; pg8::StaticOrder S; S.init(M_, N_, gdim(), bidx()); S.kwin = kwin; S.ntfull = K_ / 64;
    pg8::gemm_phase<Epi, pg8::StaticOrder, true, true>(lds, g, S, E);
}

__device__ __forceinline__ void tr_item(const float* W, int ldn, int c0, int N, bf16_t* WT, int ldw, int row_off, int koff, LAS float* scr, int item, int lane) {
    const int nblk = N / 32, kb = item / nblk, nb = item % nblk, k0 = 64 * kb, n0 = 32 * nb;
#pragma unroll 8
    for (int i = 0; i < 32; ++i) { const int kk = 2 * i + (lane >> 5); scr[kk * 33 + (lane & 31)] = W[(size_t)(k0 + kk) * ldn + c0 + n0 + (lane & 31)]; }
    asm volatile("s_waitcnt lgkmcnt(0)" ::: "memory");
    const int c = lane & 7;
#pragma unroll
    for (int j = 0; j < 4; ++j) { const int n = (lane >> 3) + 8 * j; const LAS float* s = scr + (8 * c) * 33 + n;
        u32x4 o; o.x = pk2(s[0 * 33], s[1 * 33]); o.y = pk2(s[2 * 33], s[3 * 33]); o.z = pk2(s[4 * 33], s[5 * 33]); o.w = pk2(s[6 * 33], s[7 * 33]);
        *(u32x4*)(WT + (size_t)(row_off + n0 + n) * ldw + koff + k0 + 8 * c) = o; }
    asm volatile("s_waitcnt lgkmcnt(0)" ::: "memory");
}
#define TRJOB(W, ldn, c0, K, N, WT, ldw, roff, koff) { const int cnt_ = ((K) / 64) * ((N) / 32); if (r < cnt_) { tr_item(W, ldn, c0, N, WT, ldw, roff, koff, scr, r, lane); continue; } r -= cnt_; }

struct Args { const float* in[37]; float* out; unsigned char* ws; int lo, hi; };
constexpr int TAB_OFF = 146432;
__device__ __forceinline__ const float* ldp(LAS unsigned char* lds, int i) {
    volatile LAS unsigned* t = (volatile LAS unsigned*)(lds + TAB_OFF) + 2 * i;
    const unsigned lo = (unsigned)__builtin_amdgcn_readfirstlane((int)t[0]), hi = (unsigned)__builtin_amdgcn_readfirstlane((int)t[1]);
    return (const float*)(((unsigned long long)hi << 32) | (unsigned long long)lo);
}
#define IN(i) ldp(lds, (i))
#define WSP ((unsigned char*)ldp(lds, 38))
#define OUTP ((float*)ldp(lds, 37))

__device__ __forceinline__ void convert_layer(int L, LAS unsigned char* lds) {
    const int tid = tidx(), lane = tid & 63, wave = tid >> 6;
    const int gw = bidx() * 8 + wave, NGW = gdim() * 8;
    LAS float* scr = (LAS float*)(lds + wave * 16384);
    unsigned char* wsp_ = WSP; bf16_t* WC = (bf16_t*)(wsp_ + WS_WC); bf16_t* WM = (bf16_t*)(wsp_ + WS_WM);
    const int kind = L % 3, j = L / 3;
    const float* wq = IN(32) + (size_t)L * D * D; const float* wkv = IN(33) + (size_t)L * D * 2 * D; const float* wo = IN(34) + (size_t)L * D * D;
    const float* w1 = IN(35) + (size_t)L * D * FF; const float* w2 = IN(36) + (size_t)L * FF * D;
    for (int it = gw;; it += NGW) {
        int r = it;
        TRJOB(wq, D, 0, D, D, WC + WC_Q / 2, D, 0, 0)
        TRJOB(wkv, 2 * D, 0, D, D, WC + WC_K / 2, D, 0, 0)
        TRJOB(wkv, 2 * D, D, D, D, WC + WC_V / 2, D, 0, 0)
        TRJOB(wo, D, 0, D, D, WC + WC_O / 2, D, 0, 0)
        TRJOB(w1, FF, 0, D, FF, WC + WC_W1 / 2, D, 0, 0)
        TRJOB(w2, D, 0, FF, D, WC + WC_W2 / 2, FF, 0, 0)
        if (kind == 0) {
            const float* win = IN(4) + (size_t)j * D * 2 * DR; const float* wout = IN(10) + (size_t)j * DR * D;
            TRJOB(win, 2 * DR, 0, D, DR, WM, D, 0, 0)
            TRJOB(win, 2 * DR, DR, D, DR, WM, D, DP, 0)
            TRJOB(wout, D, 0, DR, D, WM + 15 * MiB / 2, DP, 0, 0)
        } else if (kind == 1) {
            const float* wr = IN(12) + (size_t)j * D * D; const float* wk = IN(13) + (size_t)j * D * D; const float* wv = IN(14) + (size_t)j * D * D; const float* wo2 = IN(28) + (size_t)j * D * D;
            TRJOB(wr, D, 0, D, D, WM, D, 0, 0)
            TRJOB(wk, D, 0, D, D, WM, D, D, 0)
            TRJOB(wv, D, 0, D, D, WM, D, 2 * D, 0)
            TRJOB(wo2, D, 0, D, D, WM + 10 * MiB / 2, D, 0, 0)
        } else {
            const float* wqkv = IN(29) + (size_t)j * D * 3 * D; const float* wo2 = IN(31) + (size_t)j * D * D;
            TRJOB(wqkv, 3 * D, 0, D, 2 * D, WM, D, 0, 0)
            TRJOB(wqkv, 3 * D, 2 * D, D, D, WM + 4 * MiB / 2, D, 0, 0)
            TRJOB(wo2, D, 0, D, D, WM + 6 * MiB / 2, D, 0, 0)
        }
        break;
    }
    const int gt = bidx() * 512 + tid, NGT = gdim() * 512;
    if (kind == 0) {
        const float* gwt = IN(7) + (size_t)j * 2 * 16 * 84 * 84;
        bf16_t* GW = WM + 6 * MiB / 2;
        for (int idx = gt; idx < 3072 * (DP / 8); idx += NGT) {
            const int n = idx / (DP / 8), k0 = (idx % (DP / 8)) * 8; const int g = n / DP, cc = n % DP; float v[8];
#pragma unroll
            for (int e = 0; e < 8; ++e) { const int k = k0 + e; v[e] = (cc < DR && k < DR && (cc / 84) == (k / 84)) ? gwt[(((size_t)g * 16 + cc / 84) * 84 + (k % 84)) * 84 + (cc % 84)] : 0.f; }
            u32x4 o; o.x = pk2(v[0], v[1]); o.y = pk2(v[2], v[3]); o.z = pk2(v[4], v[5]); o.w = pk2(v[6], v[7]);
            *(u32x4*)(GW + (size_t)n * DP + k0) = o;
        }
        for (int idx = gt; idx < 2 * 192 * (D / 8); idx += NGT) {
            const int rr = idx / (D / 8), k0 = (idx % (D / 8)) * 8; const int n = (rr < 192) ? (DR + rr) : (DP + DR + rr - 192);
            *(u32x4*)(WM + (size_t)n * D + k0) = (u32x4){0u, 0u, 0u, 0u};
        }
        bf16_t* WOUT = WM + 15 * MiB / 2;
        for (int idx = gt; idx < D * 24; idx += NGT) {
            const int n = idx / 24, k0 = DR + (idx % 24) * 8;
            *(u32x4*)(WOUT + (size_t)n * DP + k0) = (u32x4){0u, 0u, 0u, 0u};
        }
    } else if (kind == 1) {
        const float* w1_ = IN(16) + (size_t)j * D * 64; const float* a1_ = IN(19) + (size_t)j * D * 64; const float* g1_ = IN(21) + (size_t)j * D * 128;
        const float* w2_ = IN(17) + (size_t)j * 64 * D; const float* a2_ = IN(20) + (size_t)j * 64 * D; const float* g2_ = IN(22) + (size_t)j * 128 * D;
        bf16_t* WL1 = WM + 6 * MiB / 2; bf16_t* WL2 = WM + 8 * MiB / 2;
        for (int idx = gt; idx < 256 * (3072 / 8); idx += NGT) {
            const int n = idx / 384, k0 = (idx % 384) * 8; float v[8];
#pragma unroll
            for (int e = 0; e < 8; ++e) { const int k = k0 + e; float x = 0.f;
                if (n < 64) { if (k < 1024) x = w1_[(size_t)k * 64 + n]; }
                else if (n < 128) { if (k >= 1024 && k < 2048) x = a1_[(size_t)(k - 1024) * 64 + (n - 64)]; }
                else { if (k >= 2048) x = g1_[(size_t)(k - 2048) * 128 + (n - 128)]; }
                v[e] = x; }
            u32x4 o; o.x = pk2(v[0], v[1]); o.y = pk2(v[2], v[3]); o.z = pk2(v[4], v[5]); o.w = pk2(v[6], v[7]);
            *(u32x4*)(WL1 + (size_t)n * 3072 + k0) = o;
        }
        for (int idx = gt; idx < 3072 * 32; idx += NGT) {
            const int n = idx / 32, k0 = (idx % 32) * 8; float v[8];
#pragma unroll
            for (int e = 0; e < 8; ++e) { const int k = k0 + e; float x = 0.f;
                if (n < 1024) { if (k < 64) x = w2_[(size_t)k * D + n]; }
                else if (n < 2048) { if (k >= 64 && k < 128) x = a2_[(size_t)(k - 64) * D + (n - 1024)]; }
                else { if (k >= 128) x = g2_[(size_t)(k - 128) * D + (n - 2048)]; }
                v[e] = x; }
            u32x4 o; o.x = pk2(v[0], v[1]); o.y = pk2(v[2], v[3]); o.z = pk2(v[4], v[5]); o.w = pk2(v[6], v[7]);
            *(u32x4*)(WL2 + (size_t)n * 256 + k0) = o;
        }
    }
}

__device__ __forceinline__ void ln_phase(float* H, bf16_t* HB, const float* g, const float* b) {
    const int tid = tidx(), lane = tid & 63, wave = tid >> 6;
    const int gw = bidx() * 8 + wave, NGW = gdim() * 8;
    f32x4 gv[4], bv[4];
#pragma unroll
    for (int j = 0; j < 4; ++j) { gv[j] = *(const f32x4*)(g + 256 * j + 4 * lane); bv[j] = *(const f32x4*)(b + 256 * j + 4 * lane); }
    for (int m = gw; m < M; m += NGW) {
        float* row = H + (size_t)m * D + 4 * lane; f32x4 v[4]; float s = 0.f;
#pragma unroll
        for (int j = 0; j < 4; ++j) { v[j] = *(const f32x4*)(row + 256 * j); s += (v[j].x + v[j].y) + (v[j].z + v[j].w); }
#pragma unroll
        for (int o = 1; o < 64; o <<= 1) s += __shfl_xor(s, o);
        const float mean = s * (1.f / D); float s2 = 0.f;
#pragma unroll
        for (int j = 0; j < 4; ++j) { v[j] = v[j] - mean; s2 += (v[j].x * v[j].x + v[j].y * v[j].y) + (v[j].z * v[j].z + v[j].w * v[j].w); }
#pragma unroll
        for (int o = 1; o < 64; o <<= 1) s2 += __shfl_xor(s2, o);
        const float rstd = 1.f / sqrtf(s2 * (1.f / D) + LN_EPS);
        bf16_t* hb = HB + (size_t)m * D + 4 * lane;
#pragma unroll
        for (int j = 0; j < 4; ++j) { const f32x4 y = v[j] * rstd * gv[j] + bv[j]; *(f32x4*)(row + 256 * j) = y;
            u32x2 w; w.x = pk2(y.x, y.y); w.y = pk2(y.z, y.w); *(u32x2*)(hb + 256 * j) = w; }
    }
}
#define XB_TMO      128
#define XB_XCNT(j)  (256  + 64 * (j))
#define XB_XSUB(j)  (1280 + 64 * (j))
#define XB_XGEN(j)  (2304 + 64 * (j))
#define XB_TOP      3328
#define XB_TOPGEN   3392
#define XCD_BAR_WORDS 3456
#define XB_SPIN_CAP (1u << 18)

__device__ __forceinline__ unsigned xb_ld(unsigned* p)              { return __hip_atomic_load(p, __ATOMIC_RELAXED, __HIP_MEMORY_SCOPE_AGENT); }
__device__ __forceinline__ unsigned xb_add(unsigned* p, unsigned v) { return __hip_atomic_fetch_add(p, v, __ATOMIC_RELAXED, __HIP_MEMORY_SCOPE_AGENT); }
__device__ __forceinline__ unsigned xb_xcc_id() { return (unsigned)__builtin_amdgcn_s_getreg((3 << 11) | 20) & 0xFu; }
#define XB_SPIN(cond, bar) do { unsigned _sp = 0; while (cond) { __builtin_amdgcn_s_sleep(1); \
    if ((++_sp & 255u) == 0u) { if (xb_ld(&(bar)[XB_TMO])) break; if (_sp > XB_SPIN_CAP) { atomicAdd(&(bar)[XB_TMO], 1u); break; } } } } while (0)

struct XcdBarrier {
    unsigned* bar; unsigned x;
    volatile LAS unsigned* st;
};

__device__ __forceinline__ XcdBarrier xcd_barrier_post(unsigned* bar, volatile LAS unsigned* st) {
    XcdBarrier b; b.bar = bar; b.x = xb_xcc_id(); b.st = st;
    if (tidx() == 0) (void)xb_add(&bar[XB_XCNT(b.x)], 1u);
    return b;
}
__device__ __forceinline__ void xcd_barrier_complete(unsigned* bar, unsigned x, unsigned& nloc, unsigned& nx) {
    const unsigned G = gridDim.x * gridDim.y * gridDim.z;
    unsigned sum, cnt, mine, sp = 0u;
    for (;;) {
        sum = 0u; cnt = 0u; mine = 0u;
#pragma unroll
        for (unsigned j = 0; j < 16; ++j) { const unsigned c = xb_ld(&bar[XB_XCNT(j)]); sum += c; cnt += (c > 0u) ? 1u : 0u; mine = (j == x) ? c : mine; }
        if (sum == G) break;
        __builtin_amdgcn_s_sleep(1);
        if ((++sp & 255u) == 0u) { if (xb_ld(&bar[XB_TMO])) break; if (sp > XB_SPIN_CAP) { atomicAdd(&bar[XB_TMO], 1u); break; } }
    }
    nloc = mine > 0u ? mine : 1u; nx = cnt > 0u ? cnt : 1u;
}

__device__ __forceinline__ void xcd_barrier(const XcdBarrier& b) {
    asm volatile("s_waitcnt vmcnt(0)" ::: "memory");
    __syncthreads();
    if (tidx() == 0) {
        unsigned* bar = b.bar;
        __builtin_amdgcn_s_waitcnt(0);
        unsigned nloc = b.st[0], nx = b.st[1];
        if (nloc == 0u) { xcd_barrier_complete(bar, b.x, nloc, nx); b.st[0] = nloc; b.st[1] = nx; }
        const unsigned old = xb_add(&bar[XB_XSUB(b.x)], 1u);
        const unsigned gen = old / nloc;
        if (old + 1u == (gen + 1u) * nloc) {
            __builtin_amdgcn_fence(__ATOMIC_RELEASE, "agent");
            asm volatile("s_waitcnt vmcnt(0)" ::: "memory");
            const unsigned og = xb_add(&bar[XB_TOP], 1u);
            const unsigned tg = og / nx;
            if (og + 1u == (tg + 1u) * nx) xb_add(&bar[XB_TOPGEN], 1u);
            else XB_SPIN(xb_ld(&bar[XB_TOPGEN]) == tg, bar);
            __builtin_amdgcn_fence(__ATOMIC_ACQUIRE, "agent");
            xb_add(&bar[XB_XGEN(b.x)], 1u);
            asm volatile("s_waitcnt vmcnt(0)" ::: "memory");
        } else {
            XB_SPIN(xb_ld(&bar[XB_XGEN(b.x)]) == gen, bar);
            __builtin_amdgcn_fence(__ATOMIC_ACQUIRE, "agent");
            asm volatile("s_waitcnt vmcnt(0)" ::: "memory");
        }
    }
    __syncthreads();
}

template <int HD, int NQT, bool BIAS>
__device__ __forceinline__ void attn_task(const bf16_t* Q, int ldq, const bf16_t* K, int ldk, const bf16_t* Vt, size_t ldv, int nkeys, bf16_t* O, int ldo,
                                          const float* relb, int qpos0, int kpos0, int lane) {
    const int l16 = lane & 15, fq = lane >> 4;
    bf16x8 qf[NQT][HD / 32];
#pragma unroll
    for (int t = 0; t < NQT; ++t)
#pragma unroll
        for (int ds = 0; ds < HD / 32; ++ds) qf[t][ds] = *(const bf16x8*)(Q + (size_t)(16 * t + l16) * ldq + 32 * ds + 8 * fq);
    f32x4 o[NQT][HD / 16]; float mrun[NQT], lsum[NQT];
#pragma unroll
    for (int t = 0; t < NQT; ++t) { mrun[t] = -INFINITY; lsum[t] = 0.f;
#pragma unroll
        for (int dt = 0; dt < HD / 16; ++dt) o[t][dt] = (f32x4){0.f, 0.f, 0.f, 0.f}; }
    float bfar = 0.f; if (BIAS) bfar = relb[256] * LOG2E;
    for (int key0 = 0; key0 < nkeys; key0 += 32) {
        f32x4 s[NQT][2];
#pragma unroll
        for (int t = 0; t < NQT; ++t) { s[t][0] = (f32x4){0.f, 0.f, 0.f, 0.f}; s[t][1] = (f32x4){0.f, 0.f, 0.f, 0.f}; }
        const bf16_t* kp = K + (size_t)(key0 + l16) * ldk + 8 * fq;
#pragma unroll
        for (int ds = 0; ds < HD / 32; ++ds) {
            const bf16x8 k0f = *(const bf16x8*)(kp + 32 * ds), k1f = *(const bf16x8*)(kp + (size_t)16 * ldk + 32 * ds);
#pragma unroll
            for (int t = 0; t < NQT; ++t) { s[t][0] = __builtin_amdgcn_mfma_f32_16x16x32_bf16(k0f, qf[t][ds], s[t][0], 0, 0, 0); s[t][1] = __builtin_amdgcn_mfma_f32_16x16x32_bf16(k1f, qf[t][ds], s[t][1], 0, 0, 0); }
        }
        bf16x8 pf[NQT];
        const bool farstep = BIAS && (qpos0 - (kpos0 + key0 + 31) >= 128);
#pragma unroll
        for (int t = 0; t < NQT; ++t) {
            float x[8];
#pragma unroll
            for (int kb = 0; kb < 2; ++kb)
#pragma unroll
                for (int e = 0; e < 4; ++e) {
                    float bb = 0.f;
                    if (BIAS) { if (farstep) bb = bfar; else { int rel = (qpos0 + 16 * t + l16) - (kpos0 + key0 + 16 * kb + 4 * fq + e); rel = rel < -128 ? -128 : (rel > 128 ? 128 : rel); bb = relb[rel + 128] * LOG2E; } }
                    x[4 * kb + e] = s[t][kb][e] * LOG2E + bb;
                }
            float mt = fmaxf(fmaxf(fmaxf(x[0], x[1]), fmaxf(x[2], x[3])), fmaxf(fmaxf(x[4], x[5]), fmaxf(x[6], x[7])));
            mt = fmaxf(mt, __shfl_xor(mt, 16)); mt = fmaxf(mt, __shfl_xor(mt, 32));
            const float mnew = fmaxf(mrun[t], mt), scl = __builtin_amdgcn_exp2f(mrun[t] - mnew); mrun[t] = mnew;
            float ps = 0.f;
#pragma unroll
            for (int e = 0; e < 8; ++e) { x[e] = __builtin_amdgcn_exp2f(x[e] - mnew); ps += x[e]; }
            lsum[t] = lsum[t] * scl + ps;
#pragma unroll
            for (int dt = 0; dt < HD / 16; ++dt) o[t][dt] = o[t][dt] * scl;
            u32x4 w; w.x = pg8::cvt_pk_bf16(x[0], x[1]); w.y = pg8::cvt_pk_bf16(x[2], x[3]); w.z = pg8::cvt_pk_bf16(x[4], x[5]); w.w = pg8::cvt_pk_bf16(x[6], x[7]);
            pf[t] = __builtin_bit_cast(bf16x8, w);
        }
        const bf16_t* vp = Vt + (size_t)l16 * ldv + key0 + 4 * fq;
#pragma unroll
        for (int dt = 0; dt < HD / 16; ++dt) {
            const u32x2 lo = *(const u32x2*)(vp + (size_t)(16 * dt) * ldv), hi = *(const u32x2*)(vp + (size_t)(16 * dt) * ldv + 16);
            const u32x4 vv = (u32x4){lo.x, lo.y, hi.x, hi.y}; const bf16x8 vf = __builtin_bit_cast(bf16x8, vv);
#pragma unroll
            for (int t = 0; t < NQT; ++t) o[t][dt] = __builtin_amdgcn_mfma_f32_16x16x32_bf16(vf, pf[t], o[t][dt], 0, 0, 0);
        }
    }
#pragma unroll
    for (int t = 0; t < NQT; ++t) {
        float l = lsum[t]; l += __shfl_xor(l, 16); l += __shfl_xor(l, 32); const float inv = 1.0f / l;
        bf16_t* op = O + (size_t)(16 * t + l16) * ldo + 4 * fq;
#pragma unroll
        for (int dt = 0; dt < HD / 16; ++dt) { const f32x4 v = o[t][dt] * inv; u32x2 w; w.x = pg8::cvt_pk_bf16(v[0], v[1]); w.y = pg8::cvt_pk_bf16(v[2], v[3]); *(u32x2*)(op + 16 * dt) = w; }
    }
}
__device__ __forceinline__ void chunk_attn_phase(const bf16_t* QK, const bf16_t* Vt, bf16_t* O, const float* relb) {
    const int tid = tidx(), lane = tid & 63, wave = tid >> 6;
    for (int task = bidx() * 8 + wave; task < 16384; task += gdim() * 8) {
        const int half = task & 1, c = (task >> 1) & 31, h = (task >> 6) & 15, b = task >> 10;
        const int kc0 = c > 8 ? c - 8 : 0;
        const size_t qrow = (size_t)b * SEQ + c * 64 + half * 32, krow = (size_t)b * SEQ + kc0 * 64;
        attn_task<64, 2, true>(QK + qrow * 2048 + h * 64, 2048, QK + krow * 2048 + 1024 + h * 64, 2048, Vt + (size_t)(h * 64) * M + krow, (size_t)M, (c + 1 - kc0) * 64,
                               O + qrow * D + h * 64, D, relb + h * 257, c * 64 + half * 32, kc0 * 64, lane);
    }
}
__device__ __forceinline__ void mem_attn_phase(const bf16_t* Qx, const bf16_t* Km, const bf16_t* Vtm, bf16_t* O) {
    const int tid = tidx(), lane = tid & 63, wave = tid >> 6;
    for (int task = bidx() * 8 + wave; task < 8192; task += gdim() * 8) {
        const int qt = task & 127, mh = (task >> 7) & 3, b = task >> 9;
        const size_t qrow = (size_t)b * SEQ + qt * 16;
        attn_task<256, 1, false>(Qx + qrow * D + mh * 256, D, Km + (size_t)(b * MEMT) * D + mh * 256, D, Vtm + (size_t)(mh * 256) * MM + b * MEMT, (size_t)MM, MEMT,
                                 O + qrow * D + mh * 256, D, nullptr, 0, 0, lane);
    }
}


template <int HD, bool BIAS>
__device__ __forceinline__ void attn_wg(LAS unsigned char* lds, const bf16_t* Qw, int ldq, const bf16_t* Kg, int ldk, const bf16_t* Vg, size_t ldv, int ntiles, int wt0, int wt1,
                                        bf16_t* Ow, int ldo, const float* relb, int qpos0, int kpos0, int tid) {
    constexpr int KP = 2 * HD + 16, VP = 144, KBUF = 64 * KP, BUF = KBUF + HD * VP, NCH = HD / 64;
    const int lane = tid & 63, l16 = lane & 15, fq = lane >> 4;
    bf16x8 qf[HD / 32];
#pragma unroll
    for (int ds = 0; ds < HD / 32; ++ds) qf[ds] = *(const bf16x8*)(Qw + (size_t)l16 * ldq + 32 * ds + 8 * fq);
    f32x4 o[HD / 16]; float mrun = -INFINITY, lsum = 0.f;
#pragma unroll
    for (int dt = 0; dt < HD / 16; ++dt) o[dt] = (f32x4){0.f, 0.f, 0.f, 0.f};
    float bfar = 0.f; if (BIAS) bfar = relb[256] * LOG2E;
    u32x4 kst[NCH], vst[NCH];
#define ATT_GLOAD(t_) do { _Pragma("unroll") for (int i_ = 0; i_ < NCH; ++i_) { const int id_ = tid + 512 * i_; \
        kst[i_] = *(const u32x4*)(Kg + (size_t)((t_) * 64 + id_ / (HD / 8)) * ldk + (id_ % (HD / 8)) * 8); \
        vst[i_] = *(const u32x4*)(Vg + (size_t)(id_ >> 3) * ldv + (t_) * 64 + (id_ & 7) * 8); } } while (0)
#define ATT_LSTORE(b_) do { _Pragma("unroll") for (int i_ = 0; i_ < NCH; ++i_) { const int id_ = tid + 512 * i_; \
        *(LAS u32x4*)(lds + (b_) * BUF + (id_ / (HD / 8)) * KP + (id_ % (HD / 8)) * 16) = kst[i_]; \
        *(LAS u32x4*)(lds + (b_) * BUF + KBUF + (id_ >> 3) * VP + (id_ & 7) * 16) = vst[i_]; } } while (0)
    { int nt_ = ntiles; asm volatile("" : "+v"(nt_)); ntiles = __builtin_amdgcn_readfirstlane(nt_); }
    ATT_GLOAD(0); ATT_LSTORE(0);
    __syncthreads();
#pragma unroll 1
    for (int t = 0; t < ntiles; ++t) {
        if (t + 1 < ntiles) ATT_GLOAD(t + 1);
        if (t >= wt0 && t < wt1) {
            const LAS unsigned char* kb_ = lds + (t & 1) * BUF; const LAS unsigned char* vb_ = kb_ + KBUF;
#pragma unroll 1
            for (int step = 0; step < 2; ++step) {
                f32x4 s0 = (f32x4){0.f, 0.f, 0.f, 0.f}, s1 = s0;
                const LAS unsigned char* kp = kb_ + (step * 32 + l16) * KP + 16 * fq;
#pragma unroll
                for (int ds = 0; ds < HD / 32; ++ds) {
                    const bf16x8 k0f = *(const LAS bf16x8*)(kp + 64 * ds), k1f = *(const LAS bf16x8*)(kp + 16 * KP + 64 * ds);
                    s0 = __builtin_amdgcn_mfma_f32_16x16x32_bf16(k0f, qf[ds], s0, 0, 0, 0); s1 = __builtin_amdgcn_mfma_f32_16x16x32_bf16(k1f, qf[ds], s1, 0, 0, 0);
                    if ((ds & 3) == 3) __builtin_amdgcn_sched_barrier(0);
                }
                float x[8];
                const int kbase = kpos0 + t * 64 + step * 32;
                const bool farstep = BIAS && (qpos0 - (kbase + 31) >= 128);
#pragma unroll
                for (int e = 0; e < 4; ++e) {
                    float b0 = 0.f, b1 = 0.f;
                    if (BIAS) { if (farstep) { b0 = bfar; b1 = bfar; } else {
                        int r0 = (qpos0 + l16) - (kbase + 4 * fq + e); int r1 = r0 - 16;
                        r0 = r0 < -128 ? -128 : (r0 > 128 ? 128 : r0); r1 = r1 < -128 ? -128 : (r1 > 128 ? 128 : r1);
                        b0 = relb[r0 + 128] * LOG2E; b1 = relb[r1 + 128] * LOG2E; } }
                    x[e] = s0[e] * LOG2E + b0; x[4 + e] = s1[e] * LOG2E + b1;
                }
                float mt = fmaxf(fmaxf(fmaxf(x[0], x[1]), fmaxf(x[2], x[3])), fmaxf(fmaxf(x[4], x[5]), fmaxf(x[6], x[7])));
                mt = fmaxf(mt, __shfl_xor(mt, 16)); mt = fmaxf(mt, __shfl_xor(mt, 32));
                const float mnew = fmaxf(mrun, mt), scl = __builtin_amdgcn_exp2f(mrun - mnew); mrun = mnew;
                float ps = 0.f;
#pragma unroll
                for (int e = 0; e < 8; ++e) { x[e] = __builtin_amdgcn_exp2f(x[e] - mnew); ps += x[e]; }
                lsum = lsum * scl + ps;
#pragma unroll
                for (int dt = 0; dt < HD / 16; ++dt) o[dt] = o[dt] * scl;
                u32x4 w; w.x = pg8::cvt_pk_bf16(x[0], x[1]); w.y = pg8::cvt_pk_bf16(x[2], x[3]); w.z = pg8::cvt_pk_bf16(x[4], x[5]); w.w = pg8::cvt_pk_bf16(x[6], x[7]);
                const bf16x8 pf = __builtin_bit_cast(bf16x8, w);
                __builtin_amdgcn_sched_barrier(0);
                const LAS unsigned char* vp = vb_ + l16 * VP + (step * 32 + 4 * fq) * 2;
#pragma unroll
                for (int dt = 0; dt < HD / 16; ++dt) {
                    const u32x2 lo = *(const LAS u32x2*)(vp + 16 * dt * VP), hi = *(const LAS u32x2*)(vp + 16 * dt * VP + 32);
                    const u32x4 vv = (u32x4){lo.x, lo.y, hi.x, hi.y};
                    o[dt] = __builtin_amdgcn_mfma_f32_16x16x32_bf16(__builtin_bit_cast(bf16x8, vv), pf, o[dt], 0, 0, 0);
                    if ((dt & 3) == 3) __builtin_amdgcn_sched_barrier(0);
                }
            }
        }
        if (t + 1 < ntiles) ATT_LSTORE((t + 1) & 1);
        __syncthreads();
    }
#undef ATT_GLOAD
#undef ATT_LSTORE
    float l = lsum; l += __shfl_xor(l, 16); l += __shfl_xor(l, 32); const float inv = 1.0f / l;
    bf16_t* op = Ow + (size_t)l16 * ldo + 4 * fq;
#pragma unroll
    for (int dt = 0; dt < HD / 16; ++dt) { const f32x4 v = o[dt] * inv; u32x2 w; w.x = pg8::cvt_pk_bf16(v[0], v[1]); w.y = pg8::cvt_pk_bf16(v[2], v[3]); *(u32x2*)(op + 16 * dt) = w; }
}
__device__ __forceinline__ void chunk_attn_phase2(LAS unsigned char* lds, const bf16_t* QK, const bf16_t* Vt, bf16_t* O, const float* relb) {
    const int tid = tidx(), wave = __builtin_amdgcn_readfirstlane(tid >> 6);
    for (int task = bidx(); task < 4096; task += gdim()) {
        const int cp = task & 15, h = (task >> 4) & 15, b = task >> 8;
        const int clo = 2 * cp, kc0 = clo > 8 ? clo - 8 : 0, c = clo + (wave >> 2), w0 = c > 8 ? c - 8 : 0;
        const size_t qrow = (size_t)b * SEQ + c * 64 + (wave & 3) * 16, krow = (size_t)b * SEQ + kc0 * 64;
        attn_wg<64, true>(lds, QK + qrow * 2048 + h * 64, 2048, QK + krow * 2048 + 1024 + h * 64, 2048, Vt + (size_t)(h * 64) * M + krow, (size_t)M, clo + 2 - kc0, w0 - kc0, c - kc0 + 1,
                          O + qrow * D + h * 64, D, relb + h * 257, c * 64 + (wave & 3) * 16, kc0 * 64, tid);
    }
}
__device__ __forceinline__ void mem_attn_phase2(LAS unsigned char* lds, const bf16_t* Qx, const bf16_t* Km, const bf16_t* Vtm, bf16_t* O) {
    const int tid = tidx(), wave = __builtin_amdgcn_readfirstlane(tid >> 6);
    for (int task = bidx(); task < 1024; task += gdim()) {
        const int qb = task & 15, mh = (task >> 4) & 3, b = task >> 6;
        const size_t qrow = (size_t)b * SEQ + qb * 128 + wave * 16;
        attn_wg<256, false>(lds, Qx + qrow * D + mh * 256, D, Km + (size_t)(b * MEMT) * D + mh * 256, D, Vtm + (size_t)(mh * 256) * MM + b * MEMT, (size_t)MM, 4, 0, 4,
                            O + qrow * D + mh * 256, D, nullptr, 0, 0, tid);
    }
}

__device__ __forceinline__ void conv_phase(const bf16_t* UX, bf16_t* XR, const float* cw, const float* cb) {
    const int gt = bidx() * 512 + tidx(), NGT = gdim() * 512;
    for (int idx = gt; idx < M * (DP / 8); idx += NGT) {
        const int m = idx / (DP / 8), c8 = (idx % (DP / 8)) * 8; u32x4 o = (u32x4){0u, 0u, 0u, 0u};
        if (c8 < DR) {
            const int t = m & (SEQ - 1); float acc[8];
#pragma unroll
            for (int e = 0; e < 8; ++e) acc[e] = cb[c8 + e];
#pragma unroll
            for (int k = 0; k < 4; ++k) { if (t - 3 + k >= 0) { const u32x4 u = *(const u32x4*)(UX + (size_t)(m - 3 + k) * DP + c8); const float* w = cw + k * DR + c8;
                    acc[0] += w[0] * bflo(u.x); acc[1] += w[1] * bfhi(u.x); acc[2] += w[2] * bflo(u.y); acc[3] += w[3] * bfhi(u.y);
                    acc[4] += w[4] * bflo(u.z); acc[5] += w[5] * bfhi(u.z); acc[6] += w[6] * bflo(u.w); acc[7] += w[7] * bfhi(u.w); } }
            o.x = pk2(acc[0], acc[1]); o.y = pk2(acc[2], acc[3]); o.z = pk2(acc[4], acc[5]); o.w = pk2(acc[6], acc[7]);
        }
        *(u32x4*)(XR + (size_t)m * DP + c8) = o;
    }
}
__device__ __forceinline__ float nexpm1_(float t) { return (t > -0.05f) ? -(t * (1.0f + t * (0.5f + t * (0.16666667f + t * 0.041666668f)))) : 1.0f - __expf(t); }
__device__ __forceinline__ void unpack8(const u32x4 u, float (&f)[8]) { f[0] = bflo(u.x); f[1] = bfhi(u.x); f[2] = bflo(u.y); f[3] = bfhi(u.y); f[4] = bflo(u.z); f[5] = bfhi(u.z); f[6] = bflo(u.w); f[7] = bfhi(u.w); }
__device__ __forceinline__ void scan_phase(LAS unsigned char* lds, const bf16_t* GATES, const bf16_t* XR, bf16_t* UG, const float* lam) {
    const int tid = tidx(), cq = tid & 3, seg = tid >> 2;
    LAS float* sA = (LAS float*)lds; LAS float* sB = sA + 4096;
    for (int unit = bidx(); unit < NB * 42; unit += gdim()) {
        const int b = unit / 42, c0 = (unit % 42) * 32 + cq * 8;
        float sp[8];
#pragma unroll
        for (int e = 0; e < 8; ++e) sp[e] = 8.0f * softplus_(-lam[c0 + e]);
        const size_t m0 = (size_t)b * SEQ + seg * 16;
        float A[8], B[8];
#pragma unroll
        for (int e = 0; e < 8; ++e) { A[e] = 1.f; B[e] = 0.f; }
#pragma unroll 4
        for (int t = 0; t < 16; ++t) {
            const size_t m = m0 + t; float r[8], ig[8], x[8];
            unpack8(*(const u32x4*)(GATES + m * 3072 + c0), r); unpack8(*(const u32x4*)(GATES + m * 3072 + DP + c0), ig); unpack8(*(const u32x4*)(XR + m * DP + c0), x);
#pragma unroll
            for (int e = 0; e < 8; ++e) { const float la = -sp[e] * r[e], av = __expf(la), bt = sqrtf(nexpm1_(2.0f * la)) * (ig[e] * x[e]); B[e] = av * B[e] + bt; A[e] *= av; }
        }
        { LAS float* pa = sA + seg * 32 + cq * 8; LAS float* pb = sB + seg * 32 + cq * 8;
          *(LAS f32x4*)pa = (f32x4){A[0], A[1], A[2], A[3]}; *(LAS f32x4*)(pa + 4) = (f32x4){A[4], A[5], A[6], A[7]};
          *(LAS f32x4*)pb = (f32x4){B[0], B[1], B[2], B[3]}; *(LAS f32x4*)(pb + 4) = (f32x4){B[4], B[5], B[6], B[7]}; }
        __syncthreads();
        if (tid < 32) { float hh = 0.f;
#pragma unroll 8
            for (int s2 = 0; s2 < 128; ++s2) { const float a = sA[s2 * 32 + tid], bb = sB[s2 * 32 + tid]; sB[s2 * 32 + tid] = hh; hh = a * hh + bb; } }
        __syncthreads();
        float h[8];
        { const LAS float* pb = sB + seg * 32 + cq * 8; const f32x4 h0 = *(const LAS f32x4*)pb, h1 = *(const LAS f32x4*)(pb + 4);
          h[0] = h0.x; h[1] = h0.y; h[2] = h0.z; h[3] = h0.w; h[4] = h1.x; h[5] = h1.y; h[6] = h1.z; h[7] = h1.w; }
        for (int t4 = 0; t4 < 16; t4 += 4) {
            u32x4 R4[4], I4[4], X4[4], U4[4];
#pragma unroll
            for (int q = 0; q < 4; ++q) { const size_t m = m0 + t4 + q; R4[q] = *(const u32x4*)(GATES + m * 3072 + c0); I4[q] = *(const u32x4*)(GATES + m * 3072 + DP + c0); X4[q] = *(const u32x4*)(XR + m * DP + c0); U4[q] = *(const u32x4*)(UG + m * DP + c0); }
#pragma unroll
            for (int q = 0; q < 4; ++q) {
                const size_t m = m0 + t4 + q; float r[8], ig[8], x[8], ug[8];
                unpack8(R4[q], r); unpack8(I4[q], ig); unpack8(X4[q], x); unpack8(U4[q], ug);
#pragma unroll
                for (int e = 0; e < 8; ++e) { const float la = -sp[e] * r[e], av = __expf(la), bt = sqrtf(nexpm1_(2.0f * la)) * (ig[e] * x[e]); h[e] = av * h[e] + bt; ug[e] *= h[e]; }
                u32x4 o; o.x = pk2(ug[0], ug[1]); o.y = pk2(ug[2], ug[3]); o.z = pk2(ug[4], ug[5]); o.w = pk2(ug[6], ug[7]);
                *(u32x4*)(UG + m * DP + c0) = o;
            }
        }
        __syncthreads();
    }
}

__device__ __forceinline__ void prep_phase(const float* H, bf16_t* X, const float* mu, int mode) {
    const int gt = bidx() * 512 + tidx(), NGT = gdim() * 512;
    const int i0 = mode ? 0 : 1, i1 = mode ? 2 : 4, i2 = mode ? 3 : 5;
    for (int idx = gt; idx < M * (D / 8); idx += NGT) {
        const int m = idx >> 7, c8 = (idx & 127) * 8; const int t = m & (SEQ - 1);
        const float* hp = H + (size_t)m * D + c8;
        const f32x4 h0 = *(const f32x4*)hp, h1 = *(const f32x4*)(hp + 4);
        f32x4 p0 = (f32x4){0.f, 0.f, 0.f, 0.f}, p1 = p0;
        if (t > 0) { p0 = *(const f32x4*)(hp - D); p1 = *(const f32x4*)(hp - D + 4); }
        const f32x4 x0 = p0 - h0, x1 = p1 - h1;
#pragma unroll
        for (int q = 0; q < 3; ++q) {
            const int mi = q == 0 ? i0 : (q == 1 ? i1 : i2);
            const f32x4 m0 = *(const f32x4*)(mu + mi * D + c8), m1 = *(const f32x4*)(mu + mi * D + c8 + 4);
            const f32x4 y0 = h0 + x0 * m0, y1 = h1 + x1 * m1;
            u32x4 o; o.x = pk2(y0.x, y0.y); o.y = pk2(y0.z, y0.w); o.z = pk2(y1.x, y1.y); o.w = pk2(y1.z, y1.w);
            bf16_t* dst = mode ? (X + (size_t)q * M * D + (size_t)m * D + c8) : (X + (size_t)m * 3072 + q * D + c8);
            *(u32x4*)dst = o;
        }
    }
}
__device__ __forceinline__ void rwkv_rec_phase(LAS unsigned char* lds, const bf16_t* RKV, const bf16_t* DAG, bf16_t* YG, const float* k_k, const float* k_a, const float* r_k,
                                               const float* lnx_g, const float* lnx_b) {
    LAS float* sAA = (LAS float*)lds; LAS float* sBB = sAA + 1024; LAS float* sW = sAA + 2048; LAS float* sK = sAA + 3072; LAS float* sR = sAA + 4096; LAS float* sV = sAA + 5120; LAS float* sY = sAA + 6144;
    const int tid = tidx(), tt = tid >> 5, jp = tid & 31, ri = tid >> 3, cg8 = tid & 7;
    for (int unit = bidx(); unit < 256; unit += gdim()) {
        const int b = unit >> 4, h = unit & 15, hc = h * 64 + 2 * jp;
        const float kk0 = k_k[hc], kk1 = k_k[hc + 1], ka0 = k_a[hc], ka1 = k_a[hc + 1], rk0 = r_k[hc], rk1 = r_k[hc + 1];
        const float lg0 = lnx_g[hc], lg1 = lnx_g[hc + 1], lb0 = lnx_b[hc], lb1 = lnx_b[hc + 1];
        float st[8];
#pragma unroll
        for (int e = 0; e < 8; ++e) st[e] = 0.f;
        const size_t mbase = (size_t)b * SEQ;
        unsigned pr, pk, pv, pd, pa, pg;
        { const size_t m = mbase + tt; const bf16_t* p = RKV + m * 3072 + hc; const bf16_t* q = DAG + m * 3072 + hc;
          pr = *(const unsigned*)p; pk = *(const unsigned*)(p + 1024); pv = *(const unsigned*)(p + 2048); pd = *(const unsigned*)q; pa = *(const unsigned*)(q + 1024); pg = *(const unsigned*)(q + 2048); }
        for (int blk = 0; blk < SEQ / 16; ++blk) {
            const size_t m = mbase + blk * 16 + tt;
            const float r0 = bflo(pr), r1 = bfhi(pr), k0 = bflo(pk), k1 = bfhi(pk), v0 = bflo(pv), v1 = bfhi(pv);
            const float d0 = bflo(pd), d1 = bfhi(pd), a0 = bflo(pa), a1 = bfhi(pa), g0 = bflo(pg), g1 = bfhi(pg);
            const float q0 = k0 * kk0, q1 = k1 * kk1; float ss = q0 * q0 + q1 * q1;
#pragma unroll
            for (int o = 1; o < 32; o <<= 1) ss += __shfl_xor(ss, o);
            const float inv = 1.0f / fmaxf(sqrtf(ss), 1e-12f);
            const float n0 = q0 * inv, n1 = q1 * inv;
            const float kp0 = k0 * (1.0f + (a0 - 1.0f) * ka0), kp1 = k1 * (1.0f + (a1 - 1.0f) * ka1);
            float bon = r0 * kp0 * rk0 + r1 * kp1 * rk1;
#pragma unroll
            for (int o = 1; o < 32; o <<= 1) bon += __shfl_xor(bon, o);
            const int li = tt * 64 + 2 * jp;
            *(LAS f32x2*)(sAA + li) = (f32x2){-n0, -n1}; *(LAS f32x2*)(sBB + li) = (f32x2){n0 * a0, n1 * a1};
            *(LAS f32x2*)(sW + li) = (f32x2){__expf(d0), __expf(d1)}; *(LAS f32x2*)(sK + li) = (f32x2){kp0, kp1};
            *(LAS f32x2*)(sR + li) = (f32x2){r0, r1}; *(LAS f32x2*)(sV + li) = (f32x2){v0, v1};
            __syncthreads();
            if (blk + 1 < SEQ / 16) { const size_t m2 = m + 16; const bf16_t* p = RKV + m2 * 3072 + hc; const bf16_t* q = DAG + m2 * 3072 + hc;
                pr = *(const unsigned*)p; pk = *(const unsigned*)(p + 1024); pv = *(const unsigned*)(p + 2048); pd = *(const unsigned*)q; pa = *(const unsigned*)(q + 1024); pg = *(const unsigned*)(q + 2048); }
#pragma unroll 2
            for (int t2 = 0; t2 < 16; ++t2) {
                const int lo = t2 * 64 + 8 * cg8;
                const f32x4 aa0 = *(const LAS f32x4*)(sAA + lo), aa1 = *(const LAS f32x4*)(sAA + lo + 4), ww0 = *(const LAS f32x4*)(sW + lo), ww1 = *(const LAS f32x4*)(sW + lo + 4);
                const f32x4 bb0 = *(const LAS f32x4*)(sBB + lo), bb1 = *(const LAS f32x4*)(sBB + lo + 4), kx0 = *(const LAS f32x4*)(sK + lo), kx1 = *(const LAS f32x4*)(sK + lo + 4);
                const f32x4 rr0 = *(const LAS f32x4*)(sR + lo), rr1 = *(const LAS f32x4*)(sR + lo + 4); const float vi = sV[t2 * 64 + ri];
                float sa = (st[0] * aa0.x + st[1] * aa0.y) + (st[2] * aa0.z + st[3] * aa0.w) + (st[4] * aa1.x + st[5] * aa1.y) + (st[6] * aa1.z + st[7] * aa1.w);
                sa += __shfl_xor(sa, 1); sa += __shfl_xor(sa, 2); sa += __shfl_xor(sa, 4);
                st[0] = st[0] * ww0.x + sa * bb0.x + vi * kx0.x; st[1] = st[1] * ww0.y + sa * bb0.y + vi * kx0.y; st[2] = st[2] * ww0.z + sa * bb0.z + vi * kx0.z; st[3] = st[3] * ww0.w + sa * bb0.w + vi * kx0.w;
                st[4] = st[4] * ww1.x + sa * bb1.x + vi * kx1.x; st[5] = st[5] * ww1.y + sa * bb1.y + vi * kx1.y; st[6] = st[6] * ww1.z + sa * bb1.z + vi * kx1.z; st[7] = st[7] * ww1.w + sa * bb1.w + vi * kx1.w;
                float y = (st[0] * rr0.x + st[1] * rr0.y) + (st[2] * rr0.z + st[3] * rr0.w) + (st[4] * rr1.x + st[5] * rr1.y) + (st[6] * rr1.z + st[7] * rr1.w);
                y += __shfl_xor(y, 1); y += __shfl_xor(y, 2); y += __shfl_xor(y, 4);
                if (cg8 == 0) sY[t2 * 64 + ri] = y;
            }
            __syncthreads();
            const f32x2 yy = *(const LAS f32x2*)(sY + li);
            float sm = yy.x + yy.y;
#pragma unroll
            for (int o = 1; o < 32; o <<= 1) sm += __shfl_xor(sm, o);
            const float mean = sm * (1.0f / 64.0f), e0 = yy.x - mean, e1 = yy.y - mean; float vs = e0 * e0 + e1 * e1;
#pragma unroll
            for (int o = 1; o < 32; o <<= 1) vs += __shfl_xor(vs, o);
            const float rs = 1.0f / sqrtf(vs * (1.0f / 64.0f) + 64e-5f);
            const float o0 = ((e0 * rs) * lg0 + lb0 + bon * v0) * g0, o1 = ((e1 * rs) * lg1 + lb1 + bon * v1) * g1;
            *(unsigned*)(YG + m * D + hc) = pk2(o0, o1);
        }
        __syncthreads();
    }
}

#define HAS(x) ((OPMASK >> (x)) & 1u)
enum { OP_PRO, OP_WIN, OP_CONV, OP_GATES, OP_SCAN, OP_RES, OP_LN, OP_PREP, OP_L1, OP_PLAIN, OP_L2, OP_REC, OP_CATT, OP_XATT, OP_MLP1 };

__host__ __device__ __forceinline__ void decode_phase(int pc, int& L, int& s, int& kind, int& j, int& op, int& sub) {
    if (pc < 1) { L = 0; s = -1; } else if (pc < 14) { L = 0; s = pc - 1; } else if (pc < 29) { L = 1; s = pc - 14; } else if (pc < 40) { L = 2; s = pc - 29; } else { L = 3; s = pc - 40; }
    kind = L % 3; j = L / 3; const int mlen = kind == 0 ? 6 : (kind == 1 ? 8 : 4);
    sub = 0;
    if (s < 0) op = OP_PRO;
    else if (s < mlen) {
        if (kind == 0) { op = s == 0 ? OP_WIN : s == 1 ? OP_CONV : s == 2 ? OP_GATES : s == 3 ? OP_SCAN : s == 4 ? OP_RES : OP_LN; }
        else if (kind == 1) { op = s == 0 ? OP_PREP : s == 1 ? OP_L1 : s == 2 ? OP_PREP : s == 3 ? OP_PLAIN : s == 4 ? OP_L2 : s == 5 ? OP_REC : s == 6 ? OP_RES : OP_LN; sub = (s == 2) ? 1 : 0; }
        else { op = s == 0 ? OP_PLAIN : s == 1 ? OP_CATT : s == 2 ? OP_RES : OP_LN; sub = (s == 0) ? 1 : 0; }
    } else {
        const int cs = s - mlen;
        op = cs == 0 ? OP_PLAIN : cs == 1 ? OP_XATT : cs == 2 ? OP_RES : cs == 3 ? OP_LN : cs == 4 ? OP_MLP1 : cs == 5 ? OP_RES : OP_LN;
        sub = cs == 0 ? 2 : cs == 2 ? 1 : cs == 3 ? 1 : cs == 5 ? 2 : cs == 6 ? 2 : 0;
    }
}
template <unsigned OPMASK> __global__ void __launch_bounds__(512, 2) fwd(Args a0) {
    extern __shared__ __attribute__((aligned(16))) unsigned char lds_raw[];
    LAS unsigned char* lds = (LAS unsigned char*)lds_raw;
    cg::grid_group grid = cg::this_grid();
    const int plo = a0.lo, phi = a0.hi;
    if (tidx() == 0) {
        LAS unsigned long long* tab = (LAS unsigned long long*)(lds + TAB_OFF);
#pragma unroll
        for (int i = 0; i < 37; ++i) tab[i] = (unsigned long long)a0.in[i];
        tab[37] = (unsigned long long)a0.out; tab[38] = (unsigned long long)a0.ws;
    }
    volatile LAS unsigned* bst = (volatile LAS unsigned*)(lds + TAB_OFF + 512);
    if (tidx() == 0) { bst[0] = 0u; bst[1] = 0u; }
    __syncthreads();
    XcdBarrier bar; bar.bar = (unsigned*)a0.ws; bar.x = 0; bar.st = bst;
    if (phi - plo > 1) bar = xcd_barrier_post((unsigned*)a0.ws, bst);
    for (int pc = plo; pc < phi; ++pc) {
        if (pc > plo) { if (pc == plo + 1) grid.sync(); else xcd_barrier(bar); }
        unsigned char* ws = WSP; float* H = OUTP;
        bf16_t* WC = (bf16_t*)(ws + WS_WC); bf16_t* MEMB = (bf16_t*)(ws + WS_MEMB); bf16_t* WM = (bf16_t*)(ws + WS_WM); bf16_t* HB = (bf16_t*)(ws + WS_HB);
        unsigned char* S = ws + WS_S;
        int L, s, kind, j, op, sub; decode_phase(pc, L, s, kind, j, op, sub);

#ifndef REPMASK
#define REPMASK 0u
#endif
        for (int rep = 0, reps = ((REPMASK >> op) & 1u) ? 2 : 1; rep < reps; ++rep) {
        if (rep) __syncthreads();
        if (HAS(OP_PRO) && op == OP_PRO) {
            const int gt = bidx() * 512 + tidx(), NGT = gdim() * 512;
            const float* x = IN(0); const float* mem = IN(1);
            for (int idx = gt; idx < M * D / 8; idx += NGT) { const f32x4 v0 = *(const f32x4*)(x + (size_t)idx * 8), v1 = *(const f32x4*)(x + (size_t)idx * 8 + 4);
                *(f32x4*)(H + (size_t)idx * 8) = v0; *(f32x4*)(H + (size_t)idx * 8 + 4) = v1;
                u32x4 o; o.x = pk2(v0.x, v0.y); o.y = pk2(v0.z, v0.w); o.z = pk2(v1.x, v1.y); o.w = pk2(v1.z, v1.w); *(u32x4*)(HB + (size_t)idx * 8) = o; }
            for (int idx = gt; idx < MM * D / 8; idx += NGT) { const f32x4 v0 = *(const f32x4*)(mem + (size_t)idx * 8), v1 = *(const f32x4*)(mem + (size_t)idx * 8 + 4);
                u32x4 o; o.x = pk2(v0.x, v0.y); o.y = pk2(v0.z, v0.w); o.z = pk2(v1.x, v1.y); o.w = pk2(v1.z, v1.w); *(u32x4*)(MEMB + (size_t)idx * 8) = o; }
            convert_layer(0, lds);
        }
        else if (HAS(OP_WIN) && op == OP_WIN) {
            EpiT<1> E{{(bf16_t*)S, (bf16_t*)(S + 192 * MiB), DP, nullptr, nullptr, 1.f, 0}};
            run_gemm(lds, HB, WM, M, 2 * DP, D, 1 << 30, 0, E);
        }
        else if (HAS(OP_CONV) && op == OP_CONV) { conv_phase((const bf16_t*)(S + 192 * MiB), (bf16_t*)(S + 96 * MiB), IN(5) + (size_t)j * 4 * DR, IN(6) + (size_t)j * DR); }
        else if (HAS(OP_GATES) && op == OP_GATES) {
            EpiT<2> E{{(bf16_t*)(S + 192 * MiB), nullptr, 2 * DP, IN(8) + (size_t)j * 2 * DR, nullptr, 1.f, 0}};
            run_gemm(lds, (const bf16_t*)(S + 96 * MiB), WM + 6 * MiB / 2, M, 2 * DP, DP, 1 << 30, 0, E, 1);
        }
        else if (HAS(OP_SCAN) && op == OP_SCAN) { scan_phase(lds, (const bf16_t*)(S + 192 * MiB), (const bf16_t*)(S + 96 * MiB), (bf16_t*)S, IN(9) + (size_t)j * DR); }
        else if (HAS(OP_RES) && op == OP_RES) {
            const bf16_t* A; const bf16_t* Bt; int K;
            if (sub == 0) {
                if (kind == 0) { A = (const bf16_t*)S; Bt = WM + 15 * MiB / 2; K = DP; }
                else if (kind == 1) { A = HB; Bt = WM + 10 * MiB / 2; K = D; }
                else { A = (const bf16_t*)(S + 192 * MiB); Bt = WM + 6 * MiB / 2; K = D; }
            } else if (sub == 1) { A = (const bf16_t*)(S + 64 * MiB); Bt = WC + WC_O / 2; K = D; }
            else { A = (const bf16_t*)S; Bt = WC + WC_W2 / 2; K = FF; }
            EpiRes E{H};
            run_gemm(lds, A, Bt, M, D, K, 1 << 30, 0, E);
        }
        else if (HAS(OP_LN) && op == OP_LN) {
            ln_phase(H, HB, IN(2) + (size_t)(L * 3 + sub) * D, IN(3) + (size_t)(L * 3 + sub) * D);
            if (sub == 2 && L < 3) convert_layer(L + 1, lds);
        }
        else if (HAS(OP_PREP) && op == OP_PREP) { prep_phase(H, (bf16_t*)S, IN(11) + (size_t)j * 6 * D, sub); }
        else if (HAS(OP_L1) && op == OP_L1) {
            EpiT<3> E{{HB, nullptr, 256, nullptr, nullptr, 1.f, 0}};
            run_gemm(lds, (const bf16_t*)S, WM + 6 * MiB / 2, M, 256, 3 * D, 1 << 30, 0, E);
        }
        else if (HAS(OP_L2) && op == OP_L2) {
            EpiT<4> E{{(bf16_t*)S, nullptr, 3 * D, IN(15) + (size_t)j * D, IN(18) + (size_t)j * D, 1.f, 0}};
            run_gemm(lds, HB, WM + 8 * MiB / 2, M, 3 * D, 256, 1 << 30, 0, E);
        }
        else if (HAS(OP_REC) && op == OP_REC) { rwkv_rec_phase(lds, (const bf16_t*)(S + 192 * MiB), (const bf16_t*)S, HB, IN(23) + (size_t)j * D, IN(24) + (size_t)j * D, IN(25) + (size_t)j * D, IN(26) + (size_t)j * D, IN(27) + (size_t)j * D); }
        else if (HAS(OP_PLAIN) && op == OP_PLAIN) {
            const int ng = sub == 0 ? 1 : (sub == 1 ? 2 : 3);
            for (int g = 0; g < ng; ++g) {
                const bf16_t* A; const bf16_t* Bt; int M_, N_, asplit = 1 << 30; size_t astride = 0; EpiP P{nullptr, nullptr, 0, nullptr, nullptr, 1.f, 0};
                if (sub == 0) { A = (const bf16_t*)S; Bt = WM; M_ = M; N_ = 3 * D; asplit = 4; astride = (size_t)M * D * 2; P.O = (bf16_t*)(S + 192 * MiB); P.ldc = 3 * D; }
                else if (sub == 1) {
                    if (g == 0) { A = HB; Bt = WM; M_ = M; N_ = 2 * D; P.O = (bf16_t*)S; P.ldc = 2 * D; P.scale = 0.125f; P.scale_cols = D; }
                    else { A = WM + 4 * MiB / 2; Bt = HB; M_ = D; N_ = M; P.O = (bf16_t*)(S + 128 * MiB); P.ldc = M; }
                } else {
                    if (g == 0) { A = HB; Bt = WC + WC_Q / 2; M_ = M; N_ = D; P.O = (bf16_t*)S; P.ldc = D; P.scale = 0.0625f; P.scale_cols = D; }
                    else if (g == 1) { A = MEMB; Bt = WC + WC_K / 2; M_ = MM; N_ = D; P.O = WM; P.ldc = D; }
                    else { A = WC + WC_V / 2; Bt = MEMB; M_ = D; N_ = MM; P.O = WM + 8 * MiB / 2; P.ldc = MM; }
                }
                EpiT<0> E{P};
                run_gemm(lds, A, Bt, M_, N_, D, asplit, astride, E);
            }
        }
        else if (HAS(OP_CATT) && op == OP_CATT) { chunk_attn_phase2(lds, (const bf16_t*)S, (const bf16_t*)(S + 128 * MiB), (bf16_t*)(S + 192 * MiB), IN(30) + (size_t)j * 16 * 257); }
        else if (HAS(OP_XATT) && op == OP_XATT) { mem_attn_phase2(lds, (const bf16_t*)S, WM, WM + 8 * MiB / 2, (bf16_t*)(S + 64 * MiB)); }
        else if (HAS(OP_MLP1) && op == OP_MLP1) {
            EpiT<5> E{{(bf16_t*)S, nullptr, FF, nullptr, nullptr, 1.f, 0}};
            run_gemm(lds, HB, WC + WC_W1 / 2, M, FF, D, 1 << 30, 0, E);
        }
        }
    }
}

#ifndef FULLMASK
#define FULLMASK 0xFFFFFFFFu
#endif
#ifndef MK_COOP
#define MK_COOP 0
#endif
template <unsigned MASK> static void launch_one(const Args& a, hipStream_t stream) {
    static bool attr = false;
    if (!attr) { attr = true; if (hipFuncSetAttribute((const void*)fwd<MASK>, hipFuncAttributeMaxDynamicSharedMemorySize, LDS_BYTES) != hipSuccess) fprintf(stderr, "kernel_launch: hipFuncSetAttribute failed\n"); }
    hipLaunchKernelGGL(fwd<MASK>, dim3(256), dim3(512), LDS_BYTES, stream, a);
}
extern "C" void kernel_launch(void* const* d_in, const int* in_sizes, int n_in, void* d_out, int out_size, void* d_ws, size_t ws_size, hipStream_t stream) {
    static int ready = 0;
    if (ready == 0) {
        ready = 1;
        if (n_in != 37 || out_size != M * D || ws_size < WS_END) { fprintf(stderr, "kernel_launch: unexpected shapes: n_in %d out %d ws %zu (need %zu)\n", n_in, out_size, ws_size, (size_t)WS_END); ready = -1; }
    }
    if (ready < 0) return;
    Args a{};
    for (int i = 0; i < 37; ++i) a.in[i] = (const float*)d_in[i];
    a.out = (float*)d_out; a.ws = (unsigned char*)d_ws;
#if MK_COOP
    static bool attr = false;
    if (!attr) { attr = true; if (hipFuncSetAttribute((const void*)fwd<FULLMASK>, hipFuncAttributeMaxDynamicSharedMemorySize, LDS_BYTES) != hipSuccess) fprintf(stderr, "kernel_launch: hipFuncSetAttribute failed\n"); }
    a.lo = 0; a.hi = NPHASE;
    if (hipMemsetAsync(d_ws, 0, 16384, stream) != hipSuccess) fprintf(stderr, "kernel_launch: memset of barrier words failed\n");
    void* args[] = {&a};
    hipError_t e = hipLaunchCooperativeKernel((const void*)fwd<FULLMASK>, dim3(256), dim3(512), args, LDS_BYTES, stream);
    if (e != hipSuccess) fprintf(stderr, "kernel_launch: cooperative launch failed: %s\n", hipGetErrorString(e));
#else
    for (int pc = 0; pc < NPHASE; ++pc) {
        a.lo = pc; a.hi = pc + 1;
        int L, s, kind, j, op, sub; decode_phase(pc, L, s, kind, j, op, sub);
        switch (op) {
            case OP_PRO: launch_one<1u << OP_PRO>(a, stream); break;
            case OP_WIN: launch_one<1u << OP_WIN>(a, stream); break;
            case OP_CONV: launch_one<1u << OP_CONV>(a, stream); break;
            case OP_GATES: launch_one<1u << OP_GATES>(a, stream); break;
            case OP_SCAN: launch_one<1u << OP_SCAN>(a, stream); break;
            case OP_RES: launch_one<1u << OP_RES>(a, stream); break;
            case OP_LN: launch_one<1u << OP_LN>(a, stream); break;
            case OP_PREP: launch_one<1u << OP_PREP>(a, stream); break;
            case OP_L1: launch_one<1u << OP_L1>(a, stream); break;
            case OP_PLAIN: launch_one<1u << OP_PLAIN>(a, stream); break;
            case OP_L2: launch_one<1u << OP_L2>(a, stream); break;
            case OP_REC: launch_one<1u << OP_REC>(a, stream); break;
            case OP_CATT: launch_one<1u << OP_CATT>(a, stream); break;
            case OP_XATT: launch_one<1u << OP_XATT>(a, stream); break;
            default: launch_one<1u << OP_MLP1>(a, stream); break;
        }
    }
#endif
}
```

```cpp
#include <hip/hip_runtime.h>
#include <hip/hip_cooperative_groups.h>
#include <cstdio>
#include <cstdint>
namespace cg = cooperative_groups;
__device__ __forceinline__ int tidx() { int t = (int)threadIdx.x; asm volatile("" : "+v"(t)); return t; }
__device__ __forceinline__ int bidx() { int t = (int)blockIdx.x; asm volatile("" : "+s"(t)); return t; }
__device__ __forceinline__ int gdim() { int t = (int)gridDim.x; asm volatile("" : "+s"(t)); return t; }
#define MK_COOP 1
namespace pg8 {
#define PG8_LAS __attribute__((address_space(3)))
typedef unsigned short bf16_t;
typedef short bf16x8 __attribute__((ext_vector_type(8)));
typedef float f32x4 __attribute__((ext_vector_type(4)));
typedef unsigned u32x4 __attribute__((ext_vector_type(4)));
constexpr int BM = 256, BK = 64, HALF = 128, HTB = HALF * BK * 2  , STAGE_BYTES = 8 * HTB, NXCD = 8, WGM = 8;

__host__ __device__ __forceinline__ int lds_byte(int r, int c) { const int st = (r >> 4) * 2 + (c >> 5), rr = r & 15, cc = c & 31, ob = rr * 64 + cc * 2; return st * 1024 + (ob ^ (((ob >> 9) & 1) << 5)); }
__host__ __device__ __forceinline__ void stage_rc(int b, int& R, int& C) { const int st = b / 1024, sb = b % 1024, swz = sb ^ (((sb >> 9) & 1) << 5); R = (st >> 1) * 16 + swz / 64; C = (st & 1) * 32 + (swz % 64) / 2; }
__host__ __device__ __forceinline__ int perm32(int rho) { const int n = rho >> 4, i = rho & 15; return 8 * (i >> 2) + 4 * n + (i & 3); }

struct Unit { int pm, pn, k0, nt; };
struct Gemm { const bf16_t* A; const bf16_t* Bt; int M, N, K; int asplit; size_t astride; };

struct StaticOrder {
    int nM, nN, nwg, G, c, kwin, ntfull;
    __host__ __device__ void init(int M, int N, int G_, int c_) { nM = M / BM; nN = N / BM; nwg = nM * nN; G = G_; c = c_; }
    __host__ __device__ bool next(int i, Unit& u) const {
        const long L = (long)i * G + c; if (L >= nwg) return false;
        int wgid = (int)L; { const int q = nwg / NXCD, r = nwg % NXCD, xcd = wgid % NXCD, off = wgid / NXCD; wgid = (xcd < r ? xcd * (q + 1) : r * (q + 1) + (xcd - r) * q) + off; }
        const int nig = WGM * nN, gid = wgid / nig, fm = gid * WGM, gsz = (nM - fm) < WGM ? (nM - fm) : WGM;
        u.pm = fm + ((wgid % nig) % gsz); u.pn = (wgid % nig) / gsz; u.k0 = 0; u.nt = ntfull;
        if (kwin == 1) { const int p = u.pn % 6, clo = 256 * p, chi = (clo + 255 < 1343) ? clo + 255 : 1343; const int klo = 84 * (clo / 84), khi = 84 * (chi / 84 + 1);
            int tlo = klo / 64, thi = (khi + 63) / 64; if ((thi - tlo) & 1) { if (thi < ntfull) ++thi; else --tlo; } u.k0 = tlo; u.nt = thi - tlo; }
        return true;
    }
    __device__ __forceinline__ void a_ready(const Unit&) const {}
    __device__ __forceinline__ void done(const Unit&) const {}
};

__device__ __forceinline__ unsigned cvt_pk_bf16(float lo, float hi) { unsigned r; asm volatile("v_cvt_pk_bf16_f32 %0, %1, %2" : "=v"(r) : "v"(lo), "v"(hi)); return r; }
typedef float f32x2 __attribute__((ext_vector_type(2)));
template <class Epi, class Sched, bool ALIGN_EPI = false, bool SP2 = false>
__device__ __forceinline__ void gemm_phase(PG8_LAS unsigned char* lds, const Gemm g, const Sched& S, const Epi& E) {
    const int tid = tidx(), wid = __builtin_amdgcn_readfirstlane(tid >> 6), lane = tid & 63, wr = wid >> 2, wc = wid & 3, fr = lane & 15, fq = lane >> 4;
    const int K = g.K, nt = K / BK;
    unsigned voffA[2], voffB[2];
#pragma unroll
    for (int i = 0; i < 2; ++i) { int R, C; stage_rc(tid * 16 + i * 8192, R, C); const int Rb = Epi::PERM ? ((R & ~31) + perm32(R & 31)) : R;
        voffA[i] = (unsigned)(R * K + C) * 2u; voffB[i] = (unsigned)(Rb * K + C) * 2u; }
    const size_t kstep = (size_t)(BK * 2);
    const size_t hstep = (size_t)HALF * K * 2;
    const size_t tstep = 2 * hstep;
    const unsigned ldsw = (unsigned)wid * 1024u;
    const int aoff = lds_byte(wr * 64 + fr, fq * 8), boff = lds_byte(wc * 32 + fr, fq * 8);
#define PG8_SA(b, h) (((b) * 2 + (h)) * HTB)
#define PG8_SB(b, h) ((4 + (b) * 2 + (h)) * HTB)
#define PG8_STAGE(bufoff, gbase, voff) do { _Pragma("unroll") for (int _i = 0; _i < 2; ++_i) \
        __builtin_amdgcn_global_load_lds((const unsigned*)((const char*)(gbase) + (voff)[_i]), (PG8_LAS unsigned*)(lds + (bufoff) + ldsw + _i * 8192), 16, 0, 0); } while (0)
#define PG8_LDA(dst, b, h) do { _Pragma("unroll") for (int m = 0; m < 4; ++m) _Pragma("unroll") for (int k = 0; k < 2; ++k) dst[m][k] = *(const PG8_LAS bf16x8*)(lds + PG8_SA(b, h) + aoff + m * 2048 + k * 1024); } while (0)
#define PG8_LDB(dst, b, h) do { _Pragma("unroll") for (int n = 0; n < 2; ++n) _Pragma("unroll") for (int k = 0; k < 2; ++k) dst[n][k] = *(const PG8_LAS bf16x8*)(lds + PG8_SB(b, h) + boff + n * 2048 + k * 1024); } while (0)
#define PG8_MMA(ai, bj, At, Bt) do { __builtin_amdgcn_s_setprio(1); _Pragma("unroll") for (int m = 0; m < 4; ++m) _Pragma("unroll") for (int n = 0; n < 2; ++n) _Pragma("unroll") for (int k = 0; k < 2; ++k) \
        acc[ai][bj][m][n] = __builtin_amdgcn_mfma_f32_16x16x32_bf16(Bt[n][k], At[m][k], acc[ai][bj][m][n], 0, 0, 0); __builtin_amdgcn_s_setprio(0); } while (0)
#define PG8_WAIT_V(n) asm volatile("s_waitcnt vmcnt(" #n ")" ::: "memory")
#define PG8_WAIT_L(n) asm volatile("s_waitcnt lgkmcnt(" #n ")" ::: "memory")
#define PG8_BAR __builtin_amdgcn_s_barrier()
#define PG8_SCHED __builtin_amdgcn_sched_barrier(0)
    Unit cur, nxt; int ui = 0;
    if (!S.next(0, cur)) return;
    f32x4 acc[2][2][4][2];
#pragma unroll
    for (int a = 0; a < 2; ++a)
#pragma unroll
        for (int b = 0; b < 2; ++b)
#pragma unroll
            for (int m = 0; m < 4; ++m)
#pragma unroll
                for (int n = 0; n < 2; ++n) acc[a][b][m][n] = (f32x4){0.f, 0.f, 0.f, 0.f};
    bf16x8 At[4][2], B0[2][2], B1[2][2];
    const char* cA = (const char*)g.A + (size_t)(cur.pn / g.asplit) * g.astride + (size_t)cur.pm * tstep + (size_t)cur.k0 * kstep; const char* cB = (const char*)g.Bt + (size_t)cur.pn * tstep + (size_t)cur.k0 * kstep;
    S.a_ready(cur);
    if constexpr (SP2) {
        PG8_STAGE(PG8_SB(0, 0), cB, voffB); PG8_STAGE(PG8_SB(0, 1), cB + hstep, voffB); PG8_STAGE(PG8_SA(0, 0), cA, voffA); PG8_STAGE(PG8_SA(0, 1), cA + hstep, voffA);
        if (wr == 1) PG8_BAR;
        PG8_WAIT_V(2); PG8_BAR;
        PG8_STAGE(PG8_SB(1, 0), cB + kstep, voffB); PG8_STAGE(PG8_SA(1, 0), cA + kstep, voffA); PG8_STAGE(PG8_SB(1, 1), cB + hstep + kstep, voffB);
        PG8_WAIT_V(6); PG8_BAR;
    } else {
        PG8_STAGE(PG8_SB(0, 0), cB, voffB); PG8_STAGE(PG8_SA(0, 0), cA, voffA); PG8_STAGE(PG8_SB(0, 1), cB + hstep, voffB); PG8_STAGE(PG8_SA(0, 1), cA + hstep, voffA);
        if (wr == 1) PG8_BAR;
        PG8_WAIT_V(4); PG8_BAR;
        PG8_STAGE(PG8_SB(1, 0), cB + kstep, voffB); PG8_STAGE(PG8_SA(1, 0), cA + kstep, voffA); PG8_STAGE(PG8_SB(1, 1), cB + hstep + kstep, voffB);
        PG8_WAIT_V(6); PG8_BAR;
    }
    for (;;) {
        const bool has_next = S.next(ui + 1, nxt);
        const char* nA = has_next ? (const char*)g.A + (size_t)(nxt.pn / g.asplit) * g.astride + (size_t)nxt.pm * tstep + (size_t)nxt.k0 * kstep : cA; const char* nB = has_next ? (const char*)g.Bt + (size_t)nxt.pn * tstep + (size_t)nxt.k0 * kstep : cB;
        const int unt = cur.nt;
        for (int t = 0; t < unt; t += 2) {
            const bool last = (t == unt - 2);
            const char* a1 = cA + (size_t)(t + 1) * kstep;
            const char* a2 = last ? nA : cA + (size_t)(t + 2) * kstep; const char* b2 = last ? nB : cB + (size_t)(t + 2) * kstep;
            const char* a3 = a2 + kstep; const char* b3 = b2 + kstep;
            if (last && has_next) S.a_ready(nxt);
            if constexpr (SP2) {
            PG8_LDB(B0, 0, 0); PG8_LDB(B1, 0, 1); PG8_SCHED; PG8_LDA(At, 0, 0); PG8_STAGE(PG8_SA(1, 1), a1 + hstep, voffA);
            PG8_WAIT_V(8); PG8_WAIT_L(0); PG8_BAR; PG8_MMA(0, 0, At, B0); PG8_MMA(0, 1, At, B1); PG8_BAR; PG8_SCHED;
            PG8_LDA(At, 0, 1); PG8_STAGE(PG8_SB(0, 0), b2, voffB); PG8_STAGE(PG8_SB(0, 1), b2 + hstep, voffB); PG8_STAGE(PG8_SA(0, 0), a2, voffA);
            PG8_WAIT_V(8); PG8_WAIT_L(0); PG8_BAR; PG8_MMA(1, 0, At, B0); PG8_MMA(1, 1, At, B1); PG8_BAR; PG8_SCHED;
            PG8_LDB(B0, 1, 0); PG8_LDB(B1, 1, 1); PG8_SCHED; PG8_LDA(At, 1, 0); PG8_STAGE(PG8_SA(0, 1), a2 + hstep, voffA);
            PG8_WAIT_V(8); PG8_WAIT_L(0); PG8_BAR; PG8_MMA(0, 0, At, B0); PG8_MMA(0, 1, At, B1); PG8_BAR; PG8_SCHED;
            PG8_LDA(At, 1, 1); PG8_STAGE(PG8_SB(1, 0), b3, voffB); PG8_STAGE(PG8_SB(1, 1), b3 + hstep, voffB); PG8_STAGE(PG8_SA(1, 0), a3, voffA);
            PG8_WAIT_V(8); PG8_WAIT_L(0); PG8_BAR; PG8_MMA(1, 0, At, B0); PG8_MMA(1, 1, At, B1); PG8_BAR; PG8_SCHED;
            } else {
            PG8_LDB(B0, 0, 0); PG8_SCHED; PG8_LDA(At, 0, 0); PG8_STAGE(PG8_SA(1, 1), a1 + hstep, voffA);
            PG8_WAIT_L(8); PG8_BAR; PG8_WAIT_L(0); PG8_MMA(0, 0, At, B0); PG8_BAR; PG8_SCHED;
            PG8_LDB(B1, 0, 1); PG8_STAGE(PG8_SB(0, 0), b2, voffB);
            PG8_BAR; PG8_WAIT_L(0); PG8_MMA(0, 1, At, B1); PG8_BAR;
            PG8_LDA(At, 0, 1); PG8_STAGE(PG8_SA(0, 0), a2, voffA);
            PG8_BAR; PG8_WAIT_L(0); PG8_MMA(1, 0, At, B0); PG8_BAR; PG8_SCHED;
            PG8_STAGE(PG8_SB(0, 1), b2 + hstep, voffB);
            PG8_WAIT_V(6); PG8_BAR; PG8_MMA(1, 1, At, B1); PG8_BAR;
            PG8_LDB(B0, 1, 0); PG8_SCHED; PG8_LDA(At, 1, 0); PG8_STAGE(PG8_SA(0, 1), a2 + hstep, voffA);
            PG8_WAIT_L(8); PG8_BAR; PG8_WAIT_L(0); PG8_MMA(0, 0, At, B0); PG8_BAR; PG8_SCHED;
            PG8_LDB(B1, 1, 1); PG8_STAGE(PG8_SB(1, 0), b3, voffB);
            PG8_BAR; PG8_WAIT_L(0); PG8_MMA(0, 1, At, B1); PG8_BAR;
            PG8_LDA(At, 1, 1); PG8_STAGE(PG8_SA(1, 0), a3, voffA);
            PG8_BAR; PG8_WAIT_L(0); PG8_MMA(1, 0, At, B0); PG8_BAR; PG8_SCHED;
            PG8_STAGE(PG8_SB(1, 1), b3 + hstep, voffB);
            PG8_WAIT_V(6); PG8_BAR; PG8_MMA(1, 1, At, B1); PG8_BAR;
            }
        }
        if constexpr (ALIGN_EPI) { if (wr == 0) PG8_BAR; }
        if constexpr (!Epi::AFTER_DRAIN) { E(acc, cur, wr, wc, fr, fq); S.done(cur); }
        if (!has_next) break;
#pragma unroll
        for (int a = 0; a < 2; ++a)
#pragma unroll
            for (int b = 0; b < 2; ++b)
#pragma unroll
                for (int m = 0; m < 4; ++m)
#pragma unroll
                    for (int n = 0; n < 2; ++n) acc[a][b][m][n] = (f32x4){0.f, 0.f, 0.f, 0.f};
        cur = nxt; cA = nA; cB = nB; ++ui;
        if constexpr (ALIGN_EPI) { if (wr == 1) PG8_BAR; }
    }
    PG8_WAIT_V(0);
    if constexpr (!ALIGN_EPI) { if (wr == 0) PG8_BAR; }
    PG8_BAR;
    if constexpr (Epi::AFTER_DRAIN) { E.fused(acc, cur, wr, wc, fr, fq, lds, wid, lane); S.done(cur); }
#undef PG8_SA
#undef PG8_SB
#undef PG8_STAGE
#undef PG8_LDA
#undef PG8_LDB
#undef PG8_MMA
#undef PG8_WAIT_V
#undef PG8_WAIT_L
#undef PG8_BAR
#undef PG8_SCHED
}
}

using pg8::bf16_t; using pg8::f32x4; using pg8::bf16x8; using pg8::u32x4;
#define LAS __attribute__((address_space(3)))
typedef unsigned u32x2 __attribute__((ext_vector_type(2)));
typedef float f32x2 __attribute__((ext_vector_type(2)));

constexpr int M = 32768, D = 1024, SEQ = 2048, NB = 16, DR = 1344, DP = 1536, FF = 4096, MEMT = 256, MM = NB * MEMT;
constexpr float ALPHA = 1.6817928305074290f, LN_EPS = 1e-5f, LOG2E = 1.4426950408889634f;
constexpr size_t MiB = 1u << 20;
constexpr size_t WS_WC = 1 * MiB, WS_MEMB = 25 * MiB, WS_WM = 33 * MiB, WS_HB = 53 * MiB, WS_S = 117 * MiB, WS_END = 501 * MiB;
constexpr size_t WC_Q = 0, WC_K = 2 * MiB, WC_V = 4 * MiB, WC_O = 6 * MiB, WC_W1 = 8 * MiB, WC_W2 = 16 * MiB;
constexpr int LDS_BYTES = 147456;
constexpr int NPHASE = 53;

__device__ __forceinline__ unsigned f2bf(float f) { unsigned u = __builtin_bit_cast(unsigned, f); return (u + 0x7fffu + ((u >> 16) & 1u)) >> 16; }
__device__ __forceinline__ unsigned pk2(float lo, float hi) { return f2bf(lo) | (f2bf(hi) << 16); }
__device__ __forceinline__ float bflo(unsigned u) { return __uint_as_float(u << 16); }
__device__ __forceinline__ float bfhi(unsigned u) { return __uint_as_float(u & 0xffff0000u); }
__device__ __forceinline__ float sigmoid_(float x) { return 1.0f / (1.0f + __expf(-x)); }
__device__ __forceinline__ float softplus_(float x) { return fmaxf(x, 0.f) + __logf(1.0f + __expf(-fabsf(x))); }
__device__ __forceinline__ float tanh_(float x) { return 1.0f - 2.0f / (1.0f + __expf(2.0f * x)); }
__device__ __forceinline__ float gelu_tanh_(float x) { return 0.5f * x * (1.0f + tanh_(0.7978845608028654f * (x + 0.044715f * x * x * x))); }

__device__ __forceinline__ float dpp_(float v, const int ctrl) { return v; }
#define DPP_ADD(v, ctrl) ((v) + __builtin_bit_cast(float, __builtin_amdgcn_update_dpp(0, __builtin_bit_cast(int, (v)), (ctrl), 0xF, 0xF, true)))
__device__ __forceinline__ float sum8_(float v) { v = DPP_ADD(v, 0xB1); v = DPP_ADD(v, 0x4E); v = DPP_ADD(v, 0x141); return v; }
__device__ __forceinline__ float sum16_(float v) { v = sum8_(v); v = DPP_ADD(v, 0x140); return v; }
__device__ __forceinline__ float sum32_(float v) { v = sum16_(v); v += __shfl_xor(v, 16); return v; }
__device__ __forceinline__ float sum64_(float v) { v = sum32_(v); v += __shfl_xor(v, 32); return v; }

struct EpiP { bf16_t* O; bf16_t* O2; int ldc; const float* p0; const float* p1; float scale; int scale_cols; };
template <int MODE> struct EpiT {
    static constexpr bool PERM = true, AFTER_DRAIN = false; EpiP P;
    __device__ __forceinline__ void operator()(const f32x4 (&acc)[2][2][4][2], const pg8::Unit& u, int wr, int wc, int fr, int fq) const {
        const int row0 = u.pm * 256 + wr * 64 + fr;
#pragma unroll
        for (int bj = 0; bj < 2; ++bj) {
            const int col = u.pn * 256 + bj * 128 + wc * 32 + 8 * fq;
            float bias[8];
#pragma unroll
            for (int e = 0; e < 8; ++e) bias[e] = 0.f;
            bf16_t* base = P.O; int ocol = col; float sc = 1.f;
            if (MODE == 0) { sc = (col < P.scale_cols) ? P.scale : 1.f; }
            if (MODE == 1) { if (col >= DP) { base = P.O2; ocol = col - DP; } }
            if (MODE == 2) { const int g = col / DP, cc = col - g * DP; if (cc < DR) {
#pragma unroll
                    for (int e = 0; e < 8; ++e) bias[e] = P.p0[g * DR + cc + e]; } }
            if (MODE == 4) { if (col < 2048) { const float* bp = (col < 1024) ? (P.p0 + col) : (P.p1 + (col - 1024));
#pragma unroll
                    for (int e = 0; e < 8; ++e) bias[e] = bp[e]; } }
#pragma unroll
            for (int ai = 0; ai < 2; ++ai)
#pragma unroll
                for (int m = 0; m < 4; ++m) {
                    const int row = row0 + ai * 128 + m * 16;
                    float v[8];
#pragma unroll
                    for (int e = 0; e < 4; ++e) { v[e] = acc[ai][bj][m][0][e]; v[4 + e] = acc[ai][bj][m][1][e]; }
#pragma unroll
                    for (int e = 0; e < 8; ++e) {
                        float x = v[e] + bias[e];
                        if (MODE == 0) x *= sc;
                        if (MODE == 1) { if (col < DP) x = gelu_tanh_(x); }
                        if (MODE == 2) x = sigmoid_(x);
                        if (MODE == 3) { if (col < 64) x = tanh_(x); else if (col >= 128) x = sigmoid_(x); }
                        if (MODE == 4) { if (col < 1024) { const float wl = -softplus_(-x) - 0.5f; x = -__expf(wl); } else if (col < 2048) x = sigmoid_(x); }
                        if (MODE == 5) { x = fmaxf(x, 0.f); x = x * x; }
                        v[e] = x;
                    }
                    u32x4 w; w.x = pg8::cvt_pk_bf16(v[0], v[1]); w.y = pg8::cvt_pk_bf16(v[2], v[3]); w.z = pg8::cvt_pk_bf16(v[4], v[5]); w.w = pg8::cvt_pk_bf16(v[6], v[7]);
                    *(u32x4*)(base + (size_t)row * P.ldc + ocol) = w;
                    asm volatile("" ::: "memory");
                }
        }
    }
};
struct EpiRes {
    static constexpr bool PERM = true, AFTER_DRAIN = false; float* out;
    __device__ __forceinline__ void operator()(const f32x4 (&acc)[2][2][4][2], const pg8::Unit& u, int wr, int wc, int fr, int fq) const {
        const int row0 = u.pm * 256 + wr * 64 + fr;
#pragma unroll
        for (int bj = 0; bj < 2; ++bj) {
            const int col = u.pn * 256 + bj * 128 + wc * 32 + 8 * fq;
#pragma unroll
            for (int ai = 0; ai < 2; ++ai)
#pragma unroll
                for (int m = 0; m < 4; ++m) {
                    float* p = out + (size_t)(row0 + ai * 128 + m * 16) * D + col;
                    f32x4 b0 = *(const f32x4*)p, b1 = *(const f32x4*)(p + 4);
                    b0 = b0 * ALPHA + acc[ai][bj][m][0]; b1 = b1 * ALPHA + acc[ai][bj][m][1];
                    *(f32x4*)p = b0; *(f32x4*)(p + 4) = b1;
                    if (m & 1) asm volatile("" ::: "memory");
                }
        }
    }
};

template <class Epi> __device__ __forceinline__ void run_gemm(LAS unsigned char* lds, const bf16_t* A, const bf16_t* Bt, int M_, int N_, int K_, int asplit, size_t astride, const Epi& E, int kwin = 0) {
    asm volatile("" : "+s"(K_));
    pg8::Gemm g{A, Bt, M_, N_, K_, asplit, astride}; pg8::StaticOrder S; S.init(M_, N_, gdim(), bidx()); S.kwin = kwin; S.ntfull = K_ / 64;
    pg8::gemm_phase<Epi, pg8::StaticOrder, true, true>(lds, g, S, E);
}

__device__ __forceinline__ void tr_item(const float* W, int ldn, int c0, int N, bf16_t* WT, int ldw, int row_off, int koff, LAS float* scr, int item, int lane) {
    const int nblk = N / 32, kb = item / nblk, nb = item % nblk, k0 = 64 * kb, n0 = 32 * nb;
#pragma unroll 8
    for (int i = 0; i < 32; ++i) { const int kk = 2 * i + (lane >> 5); scr[kk * 33 + (lane & 31)] = W[(size_t)(k0 + kk) * ldn + c0 + n0 + (lane & 31)]; }
    asm volatile("s_waitcnt lgkmcnt(0)" ::: "memory");
    const int c = lane & 7;
#pragma unroll
    for (int j = 0; j < 4; ++j) { const int n = (lane >> 3) + 8 * j; const LAS float* s = scr + (8 * c) * 33 + n;
        u32x4 o; o.x = pk2(s[0 * 33], s[1 * 33]); o.y = pk2(s[2 * 33], s[3 * 33]); o.z = pk2(s[4 * 33], s[5 * 33]); o.w = pk2(s[6 * 33], s[7 * 33]);
        *(u32x4*)(WT + (size_t)(row_off + n0 + n) * ldw + koff + k0 + 8 * c) = o; }
    asm volatile("s_waitcnt lgkmcnt(0)" ::: "memory");
}
#define TRJOB(W, ldn, c0, K, N, WT, ldw, roff, koff) { const int cnt_ = ((K) / 64) * ((N) / 32); if (r < cnt_) { tr_item(W, ldn, c0, N, WT, ldw, roff, koff, scr, r, lane); continue; } r -= cnt_; }

struct Args { const float* in[37]; float* out; unsigned char* ws; int lo, hi; };
constexpr int TAB_OFF = 146432;
__device__ __forceinline__ const float* ldp(LAS unsigned char* lds, int i) {
    volatile LAS unsigned* t = (volatile LAS unsigned*)(lds + TAB_OFF) + 2 * i;
    const unsigned lo = (unsigned)__builtin_amdgcn_readfirstlane((int)t[0]), hi = (unsigned)__builtin_amdgcn_readfirstlane((int)t[1]);
    return (const float*)(((unsigned long long)hi << 32) | (unsigned long long)lo);
}
#define IN(i) ldp(lds, (i))
#define WSP ((unsigned char*)ldp(lds, 38))
#define OUTP ((float*)ldp(lds, 37))

__device__ __forceinline__ void convert_layer(int L, LAS unsigned char* lds) {
    const int tid = tidx(), lane = tid & 63, wave = tid >> 6;
    const int gw = bidx() * 8 + wave, NGW = gdim() * 8;
    LAS float* scr = (LAS float*)(lds + wave * 16384);
    unsigned char* wsp_ = WSP; bf16_t* WC = (bf16_t*)(wsp_ + WS_WC); bf16_t* WM = (bf16_t*)(wsp_ + WS_WM);
    const int kind = L % 3, j = L / 3;
    const float* wq = IN(32) + (size_t)L * D * D; const float* wkv = IN(33) + (size_t)L * D * 2 * D; const float* wo = IN(34) + (size_t)L * D * D;
    const float* w1 = IN(35) + (size_t)L * D * FF; const float* w2 = IN(36) + (size_t)L * FF * D;
    for (int it = gw;; it += NGW) {
        int r = it;
        TRJOB(wq, D, 0, D, D, WC + WC_Q / 2, D, 0, 0)
        TRJOB(wkv, 2 * D, 0, D, D, WC + WC_K / 2, D, 0, 0)
        TRJOB(wkv, 2 * D, D, D, D, WC + WC_V / 2, D, 0, 0)
        TRJOB(wo, D, 0, D, D, WC + WC_O / 2, D, 0, 0)
        TRJOB(w1, FF, 0, D, FF, WC + WC_W1 / 2, D, 0, 0)
        TRJOB(w2, D, 0, FF, D, WC + WC_W2 / 2, FF, 0, 0)
        if (kind == 0) {
            const float* win = IN(4) + (size_t)j * D * 2 * DR; const float* wout = IN(10) + (size_t)j * DR * D;
            TRJOB(win, 2 * DR, 0, D, DR, WM, D, 0, 0)
            TRJOB(win, 2 * DR, DR, D, DR, WM, D, DP, 0)
            TRJOB(wout, D, 0, DR, D, WM + 15 * MiB / 2, DP, 0, 0)
        } else if (kind == 1) {
            const float* wr = IN(12) + (size_t)j * D * D; const float* wk = IN(13) + (size_t)j * D * D; const float* wv = IN(14) + (size_t)j * D * D; const float* wo2 = IN(28) + (size_t)j * D * D;
            TRJOB(wr, D, 0, D, D, WM, D, 0, 0)
            TRJOB(wk, D, 0, D, D, WM, D, D, 0)
            TRJOB(wv, D, 0, D, D, WM, D, 2 * D, 0)
            TRJOB(wo2, D, 0, D, D, WM + 10 * MiB / 2, D, 0, 0)
        } else {
            const float* wqkv = IN(29) + (size_t)j * D * 3 * D; const float* wo2 = IN(31) + (size_t)j * D * D;
            TRJOB(wqkv, 3 * D, 0, D, 2 * D, WM, D, 0, 0)
            TRJOB(wqkv, 3 * D, 2 * D, D, D, WM + 4 * MiB / 2, D, 0, 0)
            TRJOB(wo2, D, 0, D, D, WM + 6 * MiB / 2, D, 0, 0)
        }
        break;
    }
    const int gt = bidx() * 512 + tid, NGT = gdim() * 512;
    if (kind == 0) {
        const float* gwt = IN(7) + (size_t)j * 2 * 16 * 84 * 84;
        bf16_t* GW = WM + 6 * MiB / 2;
        for (int idx = gt; idx < 3072 * (DP / 8); idx += NGT) {
            const int n = idx / (DP / 8), k0 = (idx % (DP / 8)) * 8; const int g = n / DP, cc = n % DP; float v[8];
#pragma unroll
            for (int e = 0; e < 8; ++e) { const int k = k0 + e; v[e] = (cc < DR && k < DR && (cc / 84) == (k / 84)) ? gwt[(((size_t)g * 16 + cc / 84) * 84 + (k % 84)) * 84 + (cc % 84)] : 0.f; }
            u32x4 o; o.x = pk2(v[0], v[1]); o.y = pk2(v[2], v[3]); o.z = pk2(v[4], v[5]); o.w = pk2(v[6], v[7]);
            *(u32x4*)(GW + (size_t)n * DP + k0) = o;
        }
        for (int idx = gt; idx < 2 * 192 * (D / 8); idx += NGT) {
            const int rr = idx / (D / 8), k0 = (idx % (D / 8)) * 8; const int n = (rr < 192) ? (DR + rr) : (DP + DR + rr - 192);
            *(u32x4*)(WM + (size_t)n * D + k0) = (u32x4){0u, 0u, 0u, 0u};
        }
        bf16_t* WOUT = WM + 15 * MiB / 2;
        for (int idx = gt; idx < D * 24; idx += NGT) {
            const int n = idx / 24, k0 = DR + (idx % 24) * 8;
            *(u32x4*)(WOUT + (size_t)n * DP + k0) = (u32x4){0u, 0u, 0u, 0u};
        }
    } else if (kind == 1) {
        const float* w1_ = IN(16) + (size_t)j * D * 64; const float* a1_ = IN(19) + (size_t)j * D * 64; const float* g1_ = IN(21) + (size_t)j * D * 128;
        const float* w2_ = IN(17) + (size_t)j * 64 * D; const float* a2_ = IN(20) + (size_t)j * 64 * D; const float* g2_ = IN(22) + (size_t)j * 128 * D;
        bf16_t* WL1 = WM + 6 * MiB / 2; bf16_t* WL2 = WM + 8 * MiB / 2;
        for (int idx = gt; idx < 256 * (3072 / 8); idx += NGT) {
            const int n = idx / 384, k0 = (idx % 384) * 8; float v[8];
#pragma unroll
            for (int e = 0; e < 8; ++e) { const int k = k0 + e; float x = 0.f;
                if (n < 64) { if (k < 1024) x = w1_[(size_t)k * 64 + n]; }
                else if (n < 128) { if (k >= 1024 && k < 2048) x = a1_[(size_t)(k - 1024) * 64 + (n - 64)]; }
                else { if (k >= 2048) x = g1_[(size_t)(k - 2048) * 128 + (n - 128)]; }
                v[e] = x; }
            u32x4 o; o.x = pk2(v[0], v[1]); o.y = pk2(v[2], v[3]); o.z = pk2(v[4], v[5]); o.w = pk2(v[6], v[7]);
            *(u32x4*)(WL1 + (size_t)n * 3072 + k0) = o;
        }
        for (int idx = gt; idx < 3072 * 32; idx += NGT) {
            const int n = idx / 32, k0 = (idx % 32) * 8; float v[8];
#pragma unroll
            for (int e = 0; e < 8; ++e) { const int k = k0 + e; float x = 0.f;
                if (n < 1024) { if (k < 64) x = w2_[(size_t)k * D + n]; }
                else if (n < 2048) { if (k >= 64 && k < 128) x = a2_[(size_t)(k - 64) * D + (n - 1024)]; }
                else { if (k >= 128) x = g2_[(size_t)(k - 128) * D + (n - 2048)]; }
                v[e] = x; }
            u32x4 o; o.x = pk2(v[0], v[1]); o.y = pk2(v[2], v[3]); o.z = pk2(v[4], v[5]); o.w = pk2(v[6], v[7]);
            *(u32x4*)(WL2 + (size_t)n * 256 + k0) = o;
        }
    }
}

__device__ __forceinline__ void ln_phase(float* H, bf16_t* HB, const float* g, const float* b) {
    const int tid = tidx(), lane = tid & 63, wave = tid >> 6;
    const int gw = bidx() * 8 + wave, NGW = gdim() * 8;
    f32x4 gv[4], bv[4];
#pragma unroll
    for (int j = 0; j < 4; ++j) { gv[j] = *(const f32x4*)(g + 256 * j + 4 * lane); bv[j] = *(const f32x4*)(b + 256 * j + 4 * lane); }
    for (int m = gw; m < M; m += NGW) {
        float* row = H + (size_t)m * D + 4 * lane; f32x4 v[4]; float s = 0.f;
#pragma unroll
        for (int j = 0; j < 4; ++j) { v[j] = *(const f32x4*)(row + 256 * j); s += (v[j].x + v[j].y) + (v[j].z + v[j].w); }
        s = sum64_(s);
        const float mean = s * (1.f / D); float s2 = 0.f;
#pragma unroll
        for (int j = 0; j < 4; ++j) { v[j] = v[j] - mean; s2 += (v[j].x * v[j].x + v[j].y * v[j].y) + (v[j].z * v[j].z + v[j].w * v[j].w); }
        s2 = sum64_(s2);
        const float rstd = 1.f / sqrtf(s2 * (1.f / D) + LN_EPS);
        bf16_t* hb = HB + (size_t)m * D + 4 * lane;
#pragma unroll
        for (int j = 0; j < 4; ++j) { const f32x4 y = v[j] * rstd * gv[j] + bv[j]; *(f32x4*)(row + 256 * j) = y;
            u32x2 w; w.x = pk2(y.x, y.y); w.y = pk2(y.z, y.w); *(u32x2*)(hb + 256 * j) = w; }
    }
}
#define XB_TMO      128
#define XB_XCNT(j)  (256  + 64 * (j))
#define XB_XSUB(j)  (1280 + 64 * (j))
#define XB_XGEN(j)  (2304 + 64 * (j))
#define XB_TOP      3328
#define XB_TOPGEN   3392
#define XCD_BAR_WORDS 3456
#define XB_SPIN_CAP (1u << 18)

__device__ __forceinline__ unsigned xb_ld(unsigned* p)              { return __hip_atomic_load(p, __ATOMIC_RELAXED, __HIP_MEMORY_SCOPE_AGENT); }
__device__ __forceinline__ unsigned xb_add(unsigned* p, unsigned v) { return __hip_atomic_fetch_add(p, v, __ATOMIC_RELAXED, __HIP_MEMORY_SCOPE_AGENT); }
__device__ __forceinline__ unsigned xb_xcc_id() { return (unsigned)__builtin_amdgcn_s_getreg((3 << 11) | 20) & 0xFu; }
#define XB_SPIN(cond, bar) do { unsigned _sp = 0; while (cond) { __builtin_amdgcn_s_sleep(1); \
    if ((++_sp & 255u) == 0u) { if (xb_ld(&(bar)[XB_TMO])) break; if (_sp > XB_SPIN_CAP) { atomicAdd(&(bar)[XB_TMO], 1u); break; } } } } while (0)

struct XcdBarrier {
    unsigned* bar; unsigned x;
    volatile LAS unsigned* st;
};

__device__ __forceinline__ XcdBarrier xcd_barrier_post(unsigned* bar, volatile LAS unsigned* st) {
    XcdBarrier b; b.bar = bar; b.x = xb_xcc_id(); b.st = st;
    if (tidx() == 0) (void)xb_add(&bar[XB_XCNT(b.x)], 1u);
    return b;
}
__device__ __forceinline__ void xcd_barrier_complete(unsigned* bar, unsigned x, unsigned& nloc, unsigned& nx) {
    const unsigned G = gridDim.x * gridDim.y * gridDim.z;
    unsigned sum, cnt, mine, sp = 0u;
    for (;;) {
        sum = 0u; cnt = 0u; mine = 0u;
#pragma unroll
        for (unsigned j = 0; j < 16; ++j) { const unsigned c = xb_ld(&bar[XB_XCNT(j)]); sum += c; cnt += (c > 0u) ? 1u : 0u; mine = (j == x) ? c : mine; }
        if (sum == G) break;
        __builtin_amdgcn_s_sleep(1);
        if ((++sp & 255u) == 0u) { if (xb_ld(&bar[XB_TMO])) break; if (sp > XB_SPIN_CAP) { atomicAdd(&bar[XB_TMO], 1u); break; } }
    }
    nloc = mine > 0u ? mine : 1u; nx = cnt > 0u ? cnt : 1u;
}

__device__ __forceinline__ void xcd_barrier(const XcdBarrier& b) {
    asm volatile("s_waitcnt vmcnt(0)" ::: "memory");
    __syncthreads();
    if (tidx() == 0) {
        unsigned* bar = b.bar;
        __builtin_amdgcn_s_waitcnt(0);
        unsigned nloc = b.st[0], nx = b.st[1];
        if (nloc == 0u) { xcd_barrier_complete(bar, b.x, nloc, nx); b.st[0] = nloc; b.st[1] = nx; }
        const unsigned old = xb_add(&bar[XB_XSUB(b.x)], 1u);
        const unsigned gen = old / nloc;
        if (old + 1u == (gen + 1u) * nloc) {
            __builtin_amdgcn_fence(__ATOMIC_RELEASE, "agent");
            asm volatile("s_waitcnt vmcnt(0)" ::: "memory");
            const unsigned og = xb_add(&bar[XB_TOP], 1u);
            const unsigned tg = og / nx;
            if (og + 1u == (tg + 1u) * nx) xb_add(&bar[XB_TOPGEN], 1u);
            else XB_SPIN(xb_ld(&bar[XB_TOPGEN]) == tg, bar);
            __builtin_amdgcn_fence(__ATOMIC_ACQUIRE, "agent");
            xb_add(&bar[XB_XGEN(b.x)], 1u);
            asm volatile("s_waitcnt vmcnt(0)" ::: "memory");
        } else {
            XB_SPIN(xb_ld(&bar[XB_XGEN(b.x)]) == gen, bar);
            __builtin_amdgcn_fence(__ATOMIC_ACQUIRE, "agent");
            asm volatile("s_waitcnt vmcnt(0)" ::: "memory");
        }
    }
    __syncthreads();
}

template <int HD, int NQT, bool BIAS>
__device__ __forceinline__ void attn_task(const bf16_t* Q, int ldq, const bf16_t* K, int ldk, const bf16_t* Vt, size_t ldv, int nkeys, bf16_t* O, int ldo,
                                          const float* relb, int qpos0, int kpos0, int lane) {
    const int l16 = lane & 15, fq = lane >> 4;
    bf16x8 qf[NQT][HD / 32];
#pragma unroll
    for (int t = 0; t < NQT; ++t)
#pragma unroll
        for (int ds = 0; ds < HD / 32; ++ds) qf[t][ds] = *(const bf16x8*)(Q + (size_t)(16 * t + l16) * ldq + 32 * ds + 8 * fq);
    f32x4 o[NQT][HD / 16]; float mrun[NQT], lsum[NQT];
#pragma unroll
    for (int t = 0; t < NQT; ++t) { mrun[t] = -INFINITY; lsum[t] = 0.f;
#pragma unroll
        for (int dt = 0; dt < HD / 16; ++dt) o[t][dt] = (f32x4){0.f, 0.f, 0.f, 0.f}; }
    float bfar = 0.f; if (BIAS) bfar = relb[256] * LOG2E;
    for (int key0 = 0; key0 < nkeys; key0 += 32) {
        f32x4 s[NQT][2];
#pragma unroll
        for (int t = 0; t < NQT; ++t) { s[t][0] = (f32x4){0.f, 0.f, 0.f, 0.f}; s[t][1] = (f32x4){0.f, 0.f, 0.f, 0.f}; }
        const bf16_t* kp = K + (size_t)(key0 + l16) * ldk + 8 * fq;
#pragma unroll
        for (int ds = 0; ds < HD / 32; ++ds) {
            const bf16x8 k0f = *(const bf16x8*)(kp + 32 * ds), k1f = *(const bf16x8*)(kp + (size_t)16 * ldk + 32 * ds);
#pragma unroll
            for (int t = 0; t < NQT; ++t) { s[t][0] = __builtin_amdgcn_mfma_f32_16x16x32_bf16(k0f, qf[t][ds], s[t][0], 0, 0, 0); s[t][1] = __builtin_amdgcn_mfma_f32_16x16x32_bf16(k1f, qf[t][ds], s[t][1], 0, 0, 0); }
        }
        bf16x8 pf[NQT];
        const bool farstep = BIAS && (qpos0 - (kpos0 + key0 + 31) >= 128);
#pragma unroll
        for (int t = 0; t < NQT; ++t) {
            float x[8];
#pragma unroll
            for (int kb = 0; kb < 2; ++kb)
#pragma unroll
                for (int e = 0; e < 4; ++e) {
                    float bb = 0.f;
                    if (BIAS) { if (farstep) bb = bfar; else { int rel = (qpos0 + 16 * t + l16) - (kpos0 + key0 + 16 * kb + 4 * fq + e); rel = rel < -128 ? -128 : (rel > 128 ? 128 : rel); bb = relb[rel + 128] * LOG2E; } }
                    x[4 * kb + e] = s[t][kb][e] * LOG2E + bb;
                }
            float mt = fmaxf(fmaxf(fmaxf(x[0], x[1]), fmaxf(x[2], x[3])), fmaxf(fmaxf(x[4], x[5]), fmaxf(x[6], x[7])));
            mt = fmaxf(mt, __shfl_xor(mt, 16)); mt = fmaxf(mt, __shfl_xor(mt, 32));
            const float mnew = fmaxf(mrun[t], mt), scl = __builtin_amdgcn_exp2f(mrun[t] - mnew); mrun[t] = mnew;
            float ps = 0.f;
#pragma unroll
            for (int e = 0; e < 8; ++e) { x[e] = __builtin_amdgcn_exp2f(x[e] - mnew); ps += x[e]; }
            lsum[t] = lsum[t] * scl + ps;
#pragma unroll
            for (int dt = 0; dt < HD / 16; ++dt) o[t][dt] = o[t][dt] * scl;
            u32x4 w; w.x = pg8::cvt_pk_bf16(x[0], x[1]); w.y = pg8::cvt_pk_bf16(x[2], x[3]); w.z = pg8::cvt_pk_bf16(x[4], x[5]); w.w = pg8::cvt_pk_bf16(x[6], x[7]);
            pf[t] = __builtin_bit_cast(bf16x8, w);
        }
        const bf16_t* vp = Vt + (size_t)l16 * ldv + key0 + 4 * fq;
#pragma unroll
        for (int dt = 0; dt < HD / 16; ++dt) {
            const u32x2 lo = *(const u32x2*)(vp + (size_t)(16 * dt) * ldv), hi = *(const u32x2*)(vp + (size_t)(16 * dt) * ldv + 16);
            const u32x4 vv = (u32x4){lo.x, lo.y, hi.x, hi.y}; const bf16x8 vf = __builtin_bit_cast(bf16x8, vv);
#pragma unroll
            for (int t = 0; t < NQT; ++t) o[t][dt] = __builtin_amdgcn_mfma_f32_16x16x32_bf16(vf, pf[t], o[t][dt], 0, 0, 0);
        }
    }
#pragma unroll
    for (int t = 0; t < NQT; ++t) {
        float l = lsum[t]; l += __shfl_xor(l, 16); l += __shfl_xor(l, 32); const float inv = 1.0f / l;
        bf16_t* op = O + (size_t)(16 * t + l16) * ldo + 4 * fq;
#pragma unroll
        for (int dt = 0; dt < HD / 16; ++dt) { const f32x4 v = o[t][dt] * inv; u32x2 w; w.x = pg8::cvt_pk_bf16(v[0], v[1]); w.y = pg8::cvt_pk_bf16(v[2], v[3]); *(u32x2*)(op + 16 * dt) = w; }
    }
}
__device__ __forceinline__ void chunk_attn_phase(const bf16_t* QK, const bf16_t* Vt, bf16_t* O, const float* relb) {
    const int tid = tidx(), lane = tid & 63, wave = tid >> 6;
    for (int task = bidx() * 8 + wave; task < 16384; task += gdim() * 8) {
        const int half = task & 1, c = (task >> 1) & 31, h = (task >> 6) & 15, b = task >> 10;
        const int kc0 = c > 8 ? c - 8 : 0;
        const size_t qrow = (size_t)b * SEQ + c * 64 + half * 32, krow = (size_t)b * SEQ + kc0 * 64;
        attn_task<64, 2, true>(QK + qrow * 2048 + h * 64, 2048, QK + krow * 2048 + 1024 + h * 64, 2048, Vt + (size_t)(h * 64) * M + krow, (size_t)M, (c + 1 - kc0) * 64,
                               O + qrow * D + h * 64, D, relb + h * 257, c * 64 + half * 32, kc0 * 64, lane);
    }
}
__device__ __forceinline__ void mem_attn_phase(const bf16_t* Qx, const bf16_t* Km, const bf16_t* Vtm, bf16_t* O) {
    const int tid = tidx(), lane = tid & 63, wave = tid >> 6;
    for (int task = bidx() * 8 + wave; task < 8192; task += gdim() * 8) {
        const int qt = task & 127, mh = (task >> 7) & 3, b = task >> 9;
        const size_t qrow = (size_t)b * SEQ + qt * 16;
        attn_task<256, 1, false>(Qx + qrow * D + mh * 256, D, Km + (size_t)(b * MEMT) * D + mh * 256, D, Vtm + (size_t)(mh * 256) * MM + b * MEMT, (size_t)MM, MEMT,
                                 O + qrow * D + mh * 256, D, nullptr, 0, 0, lane);
    }
}


template <int HD, bool BIAS>
__device__ __forceinline__ void attn_wg(LAS unsigned char* lds, const bf16_t* Qw, int ldq, const bf16_t* Kg, int ldk, const bf16_t* Vg, size_t ldv, int ntiles, int wt0, int wt1,
                                        bf16_t* Ow, int ldo, const float* relb, int qpos0, int kpos0, int tid) {
    constexpr int KP = 2 * HD + 16, VP = 144, KBUF = 64 * KP, BUF = KBUF + HD * VP, NCH = HD / 64;
    const int lane = tid & 63, l16 = lane & 15, fq = lane >> 4;
    bf16x8 qf[HD / 32];
#pragma unroll
    for (int ds = 0; ds < HD / 32; ++ds) qf[ds] = *(const bf16x8*)(Qw + (size_t)l16 * ldq + 32 * ds + 8 * fq);
    f32x4 o[HD / 16]; float mrun = -INFINITY, lsum = 0.f;
#pragma unroll
    for (int dt = 0; dt < HD / 16; ++dt) o[dt] = (f32x4){0.f, 0.f, 0.f, 0.f};
    float bfar = 0.f; if (BIAS) bfar = relb[256] * LOG2E;
    u32x4 kst[NCH], vst[NCH];
#define ATT_GLOAD(t_) do { _Pragma("unroll") for (int i_ = 0; i_ < NCH; ++i_) { const int id_ = tid + 512 * i_; \
        kst[i_] = *(const u32x4*)(Kg + (size_t)((t_) * 64 + id_ / (HD / 8)) * ldk + (id_ % (HD / 8)) * 8); \
        vst[i_] = *(const u32x4*)(Vg + (size_t)(id_ >> 3) * ldv + (t_) * 64 + (id_ & 7) * 8); } } while (0)
#define ATT_LSTORE(b_) do { _Pragma("unroll") for (int i_ = 0; i_ < NCH; ++i_) { const int id_ = tid + 512 * i_; \
        *(LAS u32x4*)(lds + (b_) * BUF + (id_ / (HD / 8)) * KP + (id_ % (HD / 8)) * 16) = kst[i_]; \
        *(LAS u32x4*)(lds + (b_) * BUF + KBUF + (id_ >> 3) * VP + (id_ & 7) * 16) = vst[i_]; } } while (0)
    { int nt_ = ntiles; asm volatile("" : "+v"(nt_)); ntiles = __builtin_amdgcn_readfirstlane(nt_); }
    ATT_GLOAD(0); ATT_LSTORE(0);
    __syncthreads();
#pragma unroll 1
    for (int t = 0; t < ntiles; ++t) {
        if (t + 1 < ntiles) ATT_GLOAD(t + 1);
        if (t >= wt0 && t < wt1) {
            const LAS unsigned char* kb_ = lds + (t & 1) * BUF; const LAS unsigned char* vb_ = kb_ + KBUF;
#pragma unroll 1
            for (int step = 0; step < 2; ++step) {
                f32x4 s0 = (f32x4){0.f, 0.f, 0.f, 0.f}, s1 = s0;
                const LAS unsigned char* kp = kb_ + (step * 32 + l16) * KP + 16 * fq;
#pragma unroll
                for (int ds = 0; ds < HD / 32; ++ds) {
                    const bf16x8 k0f = *(const LAS bf16x8*)(kp + 64 * ds), k1f = *(const LAS bf16x8*)(kp + 16 * KP + 64 * ds);
                    s0 = __builtin_amdgcn_mfma_f32_16x16x32_bf16(k0f, qf[ds], s0, 0, 0, 0); s1 = __builtin_amdgcn_mfma_f32_16x16x32_bf16(k1f, qf[ds], s1, 0, 0, 0);
                    if ((ds & 3) == 3) __builtin_amdgcn_sched_barrier(0);
                }
                float x[8];
                const int kbase = kpos0 + t * 64 + step * 32;
                const bool farstep = BIAS && (qpos0 - (kbase + 31) >= 128);
#pragma unroll
                for (int e = 0; e < 4; ++e) {
                    float b0 = 0.f, b1 = 0.f;
                    if (BIAS) { if (farstep) { b0 = bfar; b1 = bfar; } else {
                        int r0 = (qpos0 + l16) - (kbase + 4 * fq + e); int r1 = r0 - 16;
                        r0 = r0 < -128 ? -128 : (r0 > 128 ? 128 : r0); r1 = r1 < -128 ? -128 : (r1 > 128 ? 128 : r1);
                        b0 = relb[r0 + 128] * LOG2E; b1 = relb[r1 + 128] * LOG2E; } }
                    x[e] = s0[e] * LOG2E + b0; x[4 + e] = s1[e] * LOG2E + b1;
                }
                float mt = fmaxf(fmaxf(fmaxf(x[0], x[1]), fmaxf(x[2], x[3])), fmaxf(fmaxf(x[4], x[5]), fmaxf(x[6], x[7])));
                mt = fmaxf(mt, __shfl_xor(mt, 16)); mt = fmaxf(mt, __shfl_xor(mt, 32));
                const float mnew = fmaxf(mrun, mt), scl = __builtin_amdgcn_exp2f(mrun - mnew); mrun = mnew;
                float ps = 0.f;
#pragma unroll
                for (int e = 0; e < 8; ++e) { x[e] = __builtin_amdgcn_exp2f(x[e] - mnew); ps += x[e]; }
                lsum = lsum * scl + ps;
#pragma unroll
                for (int dt = 0; dt < HD / 16; ++dt) o[dt] = o[dt] * scl;
                u32x4 w; w.x = pg8::cvt_pk_bf16(x[0], x[1]); w.y = pg8::cvt_pk_bf16(x[2], x[3]); w.z = pg8::cvt_pk_bf16(x[4], x[5]); w.w = pg8::cvt_pk_bf16(x[6], x[7]);
                const bf16x8 pf = __builtin_bit_cast(bf16x8, w);
                __builtin_amdgcn_sched_barrier(0);
                const LAS unsigned char* vp = vb_ + l16 * VP + (step * 32 + 4 * fq) * 2;
#pragma unroll
                for (int dt = 0; dt < HD / 16; ++dt) {
                    const u32x2 lo = *(const LAS u32x2*)(vp + 16 * dt * VP), hi = *(const LAS u32x2*)(vp + 16 * dt * VP + 32);
                    const u32x4 vv = (u32x4){lo.x, lo.y, hi.x, hi.y};
                    o[dt] = __builtin_amdgcn_mfma_f32_16x16x32_bf16(__builtin_bit_cast(bf16x8, vv), pf, o[dt], 0, 0, 0);
                    if ((dt & 3) == 3) __builtin_amdgcn_sched_barrier(0);
                }
            }
        }
        if (t + 1 < ntiles) ATT_LSTORE((t + 1) & 1);
        __syncthreads();
    }
#undef ATT_GLOAD
#undef ATT_LSTORE
    float l = lsum; l += __shfl_xor(l, 16); l += __shfl_xor(l, 32); const float inv = 1.0f / l;
    bf16_t* op = Ow + (size_t)l16 * ldo + 4 * fq;
#pragma unroll
    for (int dt = 0; dt < HD / 16; ++dt) { const f32x4 v = o[dt] * inv; u32x2 w; w.x = pg8::cvt_pk_bf16(v[0], v[1]); w.y = pg8::cvt_pk_bf16(v[2], v[3]); *(u32x2*)(op + 16 * dt) = w; }
}
__device__ __forceinline__ void chunk_attn_phase2(LAS unsigned char* lds, const bf16_t* QK, const bf16_t* Vt, bf16_t* O, const float* relb) {
    const int tid = tidx(), wave = __builtin_amdgcn_readfirstlane(tid >> 6);
    for (int task = bidx(); task < 4096; task += gdim()) {
        const int cp = task & 15, h = (task >> 4) & 15, b = task >> 8;
        const int clo = 2 * cp, kc0 = clo > 8 ? clo - 8 : 0, c = clo + (wave >> 2), w0 = c > 8 ? c - 8 : 0;
        const size_t qrow = (size_t)b * SEQ + c * 64 + (wave & 3) * 16, krow = (size_t)b * SEQ + kc0 * 64;
        attn_wg<64, true>(lds, QK + qrow * 2048 + h * 64, 2048, QK + krow * 2048 + 1024 + h * 64, 2048, Vt + (size_t)(h * 64) * M + krow, (size_t)M, clo + 2 - kc0, w0 - kc0, c - kc0 + 1,
                          O + qrow * D + h * 64, D, relb + h * 257, c * 64 + (wave & 3) * 16, kc0 * 64, tid);
    }
}
__device__ __forceinline__ void mem_attn_phase2(LAS unsigned char* lds, const bf16_t* Qx, const bf16_t* Km, const bf16_t* Vtm, bf16_t* O) {
    const int tid = tidx(), wave = __builtin_amdgcn_readfirstlane(tid >> 6);
    for (int task = bidx(); task < 1024; task += gdim()) {
        const int qb = task & 15, mh = (task >> 4) & 3, b = task >> 6;
        const size_t qrow = (size_t)b * SEQ + qb * 128 + wave * 16;
        attn_wg<256, false>(lds, Qx + qrow * D + mh * 256, D, Km + (size_t)(b * MEMT) * D + mh * 256, D, Vtm + (size_t)(mh * 256) * MM + b * MEMT, (size_t)MM, 4, 0, 4,
                            O + qrow * D + mh * 256, D, nullptr, 0, 0, tid);
    }
}

__device__ __forceinline__ void conv_phase(const bf16_t* UX, bf16_t* XR, const float* cw, const float* cb) {
    const int gt = bidx() * 512 + tidx(), NGT = gdim() * 512;
    for (int idx = gt; idx < M * (DP / 8); idx += NGT) {
        const int m = idx / (DP / 8), c8 = (idx % (DP / 8)) * 8; u32x4 o = (u32x4){0u, 0u, 0u, 0u};
        if (c8 < DR) {
            const int t = m & (SEQ - 1); float acc[8];
#pragma unroll
            for (int e = 0; e < 8; ++e) acc[e] = cb[c8 + e];
#pragma unroll
            for (int k = 0; k < 4; ++k) { if (t - 3 + k >= 0) { const u32x4 u = *(const u32x4*)(UX + (size_t)(m - 3 + k) * DP + c8); const float* w = cw + k * DR + c8;
                    acc[0] += w[0] * bflo(u.x); acc[1] += w[1] * bfhi(u.x); acc[2] += w[2] * bflo(u.y); acc[3] += w[3] * bfhi(u.y);
                    acc[4] += w[4] * bflo(u.z); acc[5] += w[5] * bfhi(u.z); acc[6] += w[6] * bflo(u.w); acc[7] += w[7] * bfhi(u.w); } }
            o.x = pk2(acc[0], acc[1]); o.y = pk2(acc[2], acc[3]); o.z = pk2(acc[4], acc[5]); o.w = pk2(acc[6], acc[7]);
        }
        *(u32x4*)(XR + (size_t)m * DP + c8) = o;
    }
}
__device__ __forceinline__ float nexpm1_(float t) { return (t > -0.05f) ? -(t * (1.0f + t * (0.5f + t * (0.16666667f + t * 0.041666668f)))) : 1.0f - __expf(t); }
__device__ __forceinline__ void unpack8(const u32x4 u, float (&f)[8]) { f[0] = bflo(u.x); f[1] = bfhi(u.x); f[2] = bflo(u.y); f[3] = bfhi(u.y); f[4] = bflo(u.z); f[5] = bfhi(u.z); f[6] = bflo(u.w); f[7] = bfhi(u.w); }
__device__ __forceinline__ void scan_phase(LAS unsigned char* lds, const bf16_t* GATES, const bf16_t* XR, bf16_t* UG, const float* lam) {
    const int tid = tidx(), cq = tid & 3, seg = tid >> 2;
    LAS float* sA = (LAS float*)lds; LAS float* sB = sA + 4096;
    for (int unit = bidx(); unit < NB * 42; unit += gdim()) {
        const int b = unit / 42, c0 = (unit % 42) * 32 + cq * 8;
        float sp[8];
#pragma unroll
        for (int e = 0; e < 8; ++e) sp[e] = 8.0f * softplus_(-lam[c0 + e]);
        const size_t m0 = (size_t)b * SEQ + seg * 16;
        float A[8], B[8];
#pragma unroll
        for (int e = 0; e < 8; ++e) { A[e] = 1.f; B[e] = 0.f; }
#pragma unroll 4
        for (int t = 0; t < 16; ++t) {
            const size_t m = m0 + t; float r[8], ig[8], x[8];
            unpack8(*(const u32x4*)(GATES + m * 3072 + c0), r); unpack8(*(const u32x4*)(GATES + m * 3072 + DP + c0), ig); unpack8(*(const u32x4*)(XR + m * DP + c0), x);
#pragma unroll
            for (int e = 0; e < 8; ++e) { const float la = -sp[e] * r[e], av = __expf(la), bt = sqrtf(nexpm1_(2.0f * la)) * (ig[e] * x[e]); B[e] = av * B[e] + bt; A[e] *= av; }
        }
        { LAS float* pa = sA + seg * 32 + cq * 8; LAS float* pb = sB + seg * 32 + cq * 8;
          *(LAS f32x4*)pa = (f32x4){A[0], A[1], A[2], A[3]}; *(LAS f32x4*)(pa + 4) = (f32x4){A[4], A[5], A[6], A[7]};
          *(LAS f32x4*)pb = (f32x4){B[0], B[1], B[2], B[3]}; *(LAS f32x4*)(pb + 4) = (f32x4){B[4], B[5], B[6], B[7]}; }
        __syncthreads();
        if (tid < 32) { float hh = 0.f;
#pragma unroll 8
            for (int s2 = 0; s2 < 128; ++s2) { const float a = sA[s2 * 32 + tid], bb = sB[s2 * 32 + tid]; sB[s2 * 32 + tid] = hh; hh = a * hh + bb; } }
        __syncthreads();
        float h[8];
        { const LAS float* pb = sB + seg * 32 + cq * 8; const f32x4 h0 = *(const LAS f32x4*)pb, h1 = *(const LAS f32x4*)(pb + 4);
          h[0] = h0.x; h[1] = h0.y; h[2] = h0.z; h[3] = h0.w; h[4] = h1.x; h[5] = h1.y; h[6] = h1.z; h[7] = h1.w; }
        for (int t4 = 0; t4 < 16; t4 += 4) {
            u32x4 R4[4], I4[4], X4[4], U4[4];
#pragma unroll
            for (int q = 0; q < 4; ++q) { const size_t m = m0 + t4 + q; R4[q] = *(const u32x4*)(GATES + m * 3072 + c0); I4[q] = *(const u32x4*)(GATES + m * 3072 + DP + c0); X4[q] = *(const u32x4*)(XR + m * DP + c0); U4[q] = *(const u32x4*)(UG + m * DP + c0); }
#pragma unroll
            for (int q = 0; q < 4; ++q) {
                const size_t m = m0 + t4 + q; float r[8], ig[8], x[8], ug[8];
                unpack8(R4[q], r); unpack8(I4[q], ig); unpack8(X4[q], x); unpack8(U4[q], ug);
#pragma unroll
                for (int e = 0; e < 8; ++e) { const float la = -sp[e] * r[e], av = __expf(la), bt = sqrtf(nexpm1_(2.0f * la)) * (ig[e] * x[e]); h[e] = av * h[e] + bt; ug[e] *= h[e]; }
                u32x4 o; o.x = pk2(ug[0], ug[1]); o.y = pk2(ug[2], ug[3]); o.z = pk2(ug[4], ug[5]); o.w = pk2(ug[6], ug[7]);
                *(u32x4*)(UG + m * DP + c0) = o;
            }
        }
        __syncthreads();
    }
}

__device__ __forceinline__ void prep_phase(const float* H, bf16_t* X, const float* mu, int mode) {
    const int gt = bidx() * 512 + tidx(), NGT = gdim() * 512;
    const int i0 = mode ? 0 : 1, i1 = mode ? 2 : 4, i2 = mode ? 3 : 5;
    for (int idx = gt; idx < M * (D / 8); idx += NGT) {
        const int m = idx >> 7, c8 = (idx & 127) * 8; const int t = m & (SEQ - 1);
        const float* hp = H + (size_t)m * D + c8;
        const f32x4 h0 = *(const f32x4*)hp, h1 = *(const f32x4*)(hp + 4);
        f32x4 p0 = (f32x4){0.f, 0.f, 0.f, 0.f}, p1 = p0;
        if (t > 0) { p0 = *(const f32x4*)(hp - D); p1 = *(const f32x4*)(hp - D + 4); }
        const f32x4 x0 = p0 - h0, x1 = p1 - h1;
#pragma unroll
        for (int q = 0; q < 3; ++q) {
            const int mi = q == 0 ? i0 : (q == 1 ? i1 : i2);
            const f32x4 m0 = *(const f32x4*)(mu + mi * D + c8), m1 = *(const f32x4*)(mu + mi * D + c8 + 4);
            const f32x4 y0 = h0 + x0 * m0, y1 = h1 + x1 * m1;
            u32x4 o; o.x = pk2(y0.x, y0.y); o.y = pk2(y0.z, y0.w); o.z = pk2(y1.x, y1.y); o.w = pk2(y1.z, y1.w);
            bf16_t* dst = mode ? (X + (size_t)q * M * D + (size_t)m * D + c8) : (X + (size_t)m * 3072 + q * D + c8);
            *(u32x4*)dst = o;
        }
    }
}
__device__ __forceinline__ void rwkv_rec_phase(LAS unsigned char* lds, const bf16_t* RKV, const bf16_t* DAG, bf16_t* YG, const float* k_k, const float* k_a, const float* r_k,
                                               const float* lnx_g, const float* lnx_b) {
    LAS float* sAA = (LAS float*)lds; LAS float* sBB = sAA + 1024; LAS float* sW = sAA + 2048; LAS float* sK = sAA + 3072; LAS float* sR = sAA + 4096; LAS float* sV = sAA + 5120; LAS float* sY = sAA + 6144;
    const int tid = tidx(), tt = tid >> 5, jp = tid & 31, ri = tid >> 3, cg8 = tid & 7;
    for (int unit = bidx(); unit < 256; unit += gdim()) {
        const int b = unit >> 4, h = unit & 15, hc = h * 64 + 2 * jp;
        const float kk0 = k_k[hc], kk1 = k_k[hc + 1], ka0 = k_a[hc], ka1 = k_a[hc + 1], rk0 = r_k[hc], rk1 = r_k[hc + 1];
        const float lg0 = lnx_g[hc], lg1 = lnx_g[hc + 1], lb0 = lnx_b[hc], lb1 = lnx_b[hc + 1];
        f32x2 st2[4];
#pragma unroll
        for (int e = 0; e < 4; ++e) st2[e] = (f32x2){0.f, 0.f};
        const size_t mbase = (size_t)b * SEQ;
        unsigned pr, pk, pv, pd, pa, pg;
        { const size_t m = mbase + tt; const bf16_t* p = RKV + m * 3072 + hc; const bf16_t* q = DAG + m * 3072 + hc;
          pr = *(const unsigned*)p; pk = *(const unsigned*)(p + 1024); pv = *(const unsigned*)(p + 2048); pd = *(const unsigned*)q; pa = *(const unsigned*)(q + 1024); pg = *(const unsigned*)(q + 2048); }
        for (int blk = 0; blk < SEQ / 16; ++blk) {
            const size_t m = mbase + blk * 16 + tt;
            const float r0 = bflo(pr), r1 = bfhi(pr), k0 = bflo(pk), k1 = bfhi(pk), v0 = bflo(pv), v1 = bfhi(pv);
            const float d0 = bflo(pd), d1 = bfhi(pd), a0 = bflo(pa), a1 = bfhi(pa), g0 = bflo(pg), g1 = bfhi(pg);
            const float q0 = k0 * kk0, q1 = k1 * kk1; float ss = q0 * q0 + q1 * q1;
            ss = sum32_(ss);
            const float inv = 1.0f / fmaxf(sqrtf(ss), 1e-12f);
            const float n0 = q0 * inv, n1 = q1 * inv;
            const float kp0 = k0 * (1.0f + (a0 - 1.0f) * ka0), kp1 = k1 * (1.0f + (a1 - 1.0f) * ka1);
            float bon = r0 * kp0 * rk0 + r1 * kp1 * rk1;
            bon = sum32_(bon);
            const int li = tt * 64 + 2 * jp;
            *(LAS f32x2*)(sAA + li) = (f32x2){-n0, -n1}; *(LAS f32x2*)(sBB + li) = (f32x2){n0 * a0, n1 * a1};
            *(LAS f32x2*)(sW + li) = (f32x2){__expf(d0), __expf(d1)}; *(LAS f32x2*)(sK + li) = (f32x2){kp0, kp1};
            *(LAS f32x2*)(sR + li) = (f32x2){r0, r1}; *(LAS f32x2*)(sV + li) = (f32x2){v0, v1};
            __syncthreads();
            if (blk + 1 < SEQ / 16) { const size_t m2 = m + 16; const bf16_t* p = RKV + m2 * 3072 + hc; const bf16_t* q = DAG + m2 * 3072 + hc;
                pr = *(const unsigned*)p; pk = *(const unsigned*)(p + 1024); pv = *(const unsigned*)(p + 2048); pd = *(const unsigned*)q; pa = *(const unsigned*)(q + 1024); pg = *(const unsigned*)(q + 2048); }
#pragma unroll 4
            for (int t2 = 0; t2 < 16; ++t2) {
                const int lo = t2 * 64 + 8 * cg8;
                const f32x4 aa0 = *(const LAS f32x4*)(sAA + lo), aa1 = *(const LAS f32x4*)(sAA + lo + 4), ww0 = *(const LAS f32x4*)(sW + lo), ww1 = *(const LAS f32x4*)(sW + lo + 4);
                const f32x4 bb0 = *(const LAS f32x4*)(sBB + lo), bb1 = *(const LAS f32x4*)(sBB + lo + 4), kx0 = *(const LAS f32x4*)(sK + lo), kx1 = *(const LAS f32x4*)(sK + lo + 4);
                const f32x4 rr0 = *(const LAS f32x4*)(sR + lo), rr1 = *(const LAS f32x4*)(sR + lo + 4); const float vi = sV[t2 * 64 + ri];
                f32x2 p = st2[0] * (f32x2){aa0.x, aa0.y}; p = st2[1] * (f32x2){aa0.z, aa0.w} + p; p = st2[2] * (f32x2){aa1.x, aa1.y} + p; p = st2[3] * (f32x2){aa1.z, aa1.w} + p;
                const float sa = sum8_(p.x + p.y); const f32x2 sav = (f32x2){sa, sa}, viv = (f32x2){vi, vi};
                st2[0] = st2[0] * (f32x2){ww0.x, ww0.y} + sav * (f32x2){bb0.x, bb0.y} + viv * (f32x2){kx0.x, kx0.y};
                st2[1] = st2[1] * (f32x2){ww0.z, ww0.w} + sav * (f32x2){bb0.z, bb0.w} + viv * (f32x2){kx0.z, kx0.w};
                st2[2] = st2[2] * (f32x2){ww1.x, ww1.y} + sav * (f32x2){bb1.x, bb1.y} + viv * (f32x2){kx1.x, kx1.y};
                st2[3] = st2[3] * (f32x2){ww1.z, ww1.w} + sav * (f32x2){bb1.z, bb1.w} + viv * (f32x2){kx1.z, kx1.w};
                f32x2 q = st2[0] * (f32x2){rr0.x, rr0.y}; q = st2[1] * (f32x2){rr0.z, rr0.w} + q; q = st2[2] * (f32x2){rr1.x, rr1.y} + q; q = st2[3] * (f32x2){rr1.z, rr1.w} + q;
                const float y = sum8_(q.x + q.y);
                if (cg8 == 0) sY[t2 * 64 + ri] = y;
            }
            __syncthreads();
            const f32x2 yy = *(const LAS f32x2*)(sY + li);
            float sm = yy.x + yy.y;
            sm = sum32_(sm);
            const float mean = sm * (1.0f / 64.0f), e0 = yy.x - mean, e1 = yy.y - mean; float vs = e0 * e0 + e1 * e1;
            vs = sum32_(vs);
            const float rs = 1.0f / sqrtf(vs * (1.0f / 64.0f) + 64e-5f);
            const float o0 = ((e0 * rs) * lg0 + lb0 + bon * v0) * g0, o1 = ((e1 * rs) * lg1 + lb1 + bon * v1) * g1;
            *(unsigned*)(YG + m * D + hc) = pk2(o0, o1);
        }
        __syncthreads();
    }
}

#define HAS(x) ((OPMASK >> (x)) & 1u)
enum { OP_PRO, OP_WIN, OP_CONV, OP_GATES, OP_SCAN, OP_RES, OP_LN, OP_PREP, OP_L1, OP_PLAIN, OP_L2, OP_REC, OP_CATT, OP_XATT, OP_MLP1 };

__host__ __device__ __forceinline__ void decode_phase(int pc, int& L, int& s, int& kind, int& j, int& op, int& sub) {
    if (pc < 1) { L = 0; s = -1; } else if (pc < 14) { L = 0; s = pc - 1; } else if (pc < 29) { L = 1; s = pc - 14; } else if (pc < 40) { L = 2; s = pc - 29; } else { L = 3; s = pc - 40; }
    kind = L % 3; j = L / 3; const int mlen = kind == 0 ? 6 : (kind == 1 ? 8 : 4);
    sub = 0;
    if (s < 0) op = OP_PRO;
    else if (s < mlen) {
        if (kind == 0) { op = s == 0 ? OP_WIN : s == 1 ? OP_CONV : s == 2 ? OP_GATES : s == 3 ? OP_SCAN : s == 4 ? OP_RES : OP_LN; }
        else if (kind == 1) { op = s == 0 ? OP_PREP : s == 1 ? OP_L1 : s == 2 ? OP_PREP : s == 3 ? OP_PLAIN : s == 4 ? OP_L2 : s == 5 ? OP_REC : s == 6 ? OP_RES : OP_LN; sub = (s == 2) ? 1 : 0; }
        else { op = s == 0 ? OP_PLAIN : s == 1 ? OP_CATT : s == 2 ? OP_RES : OP_LN; sub = (s == 0) ? 1 : 0; }
    } else {
        const int cs = s - mlen;
        op = cs == 0 ? OP_PLAIN : cs == 1 ? OP_XATT : cs == 2 ? OP_RES : cs == 3 ? OP_LN : cs == 4 ? OP_MLP1 : cs == 5 ? OP_RES : OP_LN;
        sub = cs == 0 ? 2 : cs == 2 ? 1 : cs == 3 ? 1 : cs == 5 ? 2 : cs == 6 ? 2 : 0;
    }
}
template <unsigned OPMASK> __global__ void __launch_bounds__(512, 2) fwd(Args a0) {
    extern __shared__ __attribute__((aligned(16))) unsigned char lds_raw[];
    LAS unsigned char* lds = (LAS unsigned char*)lds_raw;
    cg::grid_group grid = cg::this_grid();
    const int plo = a0.lo, phi = a0.hi;
    if (tidx() == 0) {
        LAS unsigned long long* tab = (LAS unsigned long long*)(lds + TAB_OFF);
#pragma unroll
        for (int i = 0; i < 37; ++i) tab[i] = (unsigned long long)a0.in[i];
        tab[37] = (unsigned long long)a0.out; tab[38] = (unsigned long long)a0.ws;
    }
    volatile LAS unsigned* bst = (volatile LAS unsigned*)(lds + TAB_OFF + 512);
    if (tidx() == 0) { bst[0] = 0u; bst[1] = 0u; }
    __syncthreads();
    XcdBarrier bar; bar.bar = (unsigned*)a0.ws; bar.x = 0; bar.st = bst;
    if (phi - plo > 1) bar = xcd_barrier_post((unsigned*)a0.ws, bst);
    for (int pc = plo; pc < phi; ++pc) {
        if (pc > plo) { if (pc == plo + 1) grid.sync(); else xcd_barrier(bar); }
        unsigned char* ws = WSP; float* H = OUTP;
        bf16_t* WC = (bf16_t*)(ws + WS_WC); bf16_t* MEMB = (bf16_t*)(ws + WS_MEMB); bf16_t* WM = (bf16_t*)(ws + WS_WM); bf16_t* HB = (bf16_t*)(ws + WS_HB);
        unsigned char* S = ws + WS_S;
        int L, s, kind, j, op, sub; decode_phase(pc, L, s, kind, j, op, sub);

#ifndef REPMASK
#define REPMASK 0u
#endif
        for (int rep = 0, reps = ((REPMASK >> op) & 1u) ? 2 : 1; rep < reps; ++rep) {
        if (rep) __syncthreads();
        if (HAS(OP_PRO) && op == OP_PRO) {
            const int gt = bidx() * 512 + tidx(), NGT = gdim() * 512;
            const float* x = IN(0); const float* mem = IN(1);
            for (int idx = gt; idx < M * D / 8; idx += NGT) { const f32x4 v0 = *(const f32x4*)(x + (size_t)idx * 8), v1 = *(const f32x4*)(x + (size_t)idx * 8 + 4);
                *(f32x4*)(H + (size_t)idx * 8) = v0; *(f32x4*)(H + (size_t)idx * 8 + 4) = v1;
                u32x4 o; o.x = pk2(v0.x, v0.y); o.y = pk2(v0.z, v0.w); o.z = pk2(v1.x, v1.y); o.w = pk2(v1.z, v1.w); *(u32x4*)(HB + (size_t)idx * 8) = o; }
            for (int idx = gt; idx < MM * D / 8; idx += NGT) { const f32x4 v0 = *(const f32x4*)(mem + (size_t)idx * 8), v1 = *(const f32x4*)(mem + (size_t)idx * 8 + 4);
                u32x4 o; o.x = pk2(v0.x, v0.y); o.y = pk2(v0.z, v0.w); o.z = pk2(v1.x, v1.y); o.w = pk2(v1.z, v1.w); *(u32x4*)(MEMB + (size_t)idx * 8) = o; }
            convert_layer(0, lds);
        }
        else if (HAS(OP_WIN) && op == OP_WIN) {
            EpiT<1> E{{(bf16_t*)S, (bf16_t*)(S + 192 * MiB), DP, nullptr, nullptr, 1.f, 0}};
            run_gemm(lds, HB, WM, M, 2 * DP, D, 1 << 30, 0, E);
        }
        else if (HAS(OP_CONV) && op == OP_CONV) { conv_phase((const bf16_t*)(S + 192 * MiB), (bf16_t*)(S + 96 * MiB), IN(5) + (size_t)j * 4 * DR, IN(6) + (size_t)j * DR); }
        else if (HAS(OP_GATES) && op == OP_GATES) {
            EpiT<2> E{{(bf16_t*)(S + 192 * MiB), nullptr, 2 * DP, IN(8) + (size_t)j * 2 * DR, nullptr, 1.f, 0}};
            run_gemm(lds, (const bf16_t*)(S + 96 * MiB), WM + 6 * MiB / 2, M, 2 * DP, DP, 1 << 30, 0, E, 1);
        }
        else if (HAS(OP_SCAN) && op == OP_SCAN) { scan_phase(lds, (const bf16_t*)(S + 192 * MiB), (const bf16_t*)(S + 96 * MiB), (bf16_t*)S, IN(9) + (size_t)j * DR); }
        else if (HAS(OP_RES) && op == OP_RES) {
            const bf16_t* A; const bf16_t* Bt; int K;
            if (sub == 0) {
                if (kind == 0) { A = (const bf16_t*)S; Bt = WM + 15 * MiB / 2; K = DP; }
                else if (kind == 1) { A = HB; Bt = WM + 10 * MiB / 2; K = D; }
                else { A = (const bf16_t*)(S + 192 * MiB); Bt = WM + 6 * MiB / 2; K = D; }
            } else if (sub == 1) { A = (const bf16_t*)(S + 64 * MiB); Bt = WC + WC_O / 2; K = D; }
            else { A = (const bf16_t*)S; Bt = WC + WC_W2 / 2; K = FF; }
            EpiRes E{H};
            run_gemm(lds, A, Bt, M, D, K, 1 << 30, 0, E);
        }
        else if (HAS(OP_LN) && op == OP_LN) {
            ln_phase(H, HB, IN(2) + (size_t)(L * 3 + sub) * D, IN(3) + (size_t)(L * 3 + sub) * D);
            if (sub == 2 && L < 3) convert_layer(L + 1, lds);
        }
        else if (HAS(OP_PREP) && op == OP_PREP) { prep_phase(H, (bf16_t*)S, IN(11) + (size_t)j * 6 * D, sub); }
        else if (HAS(OP_L1) && op == OP_L1) {
            EpiT<3> E{{HB, nullptr, 256, nullptr, nullptr, 1.f, 0}};
            run_gemm(lds, (const bf16_t*)S, WM + 6 * MiB / 2, M, 256, 3 * D, 1 << 30, 0, E);
        }
        else if (HAS(OP_L2) && op == OP_L2) {
            EpiT<4> E{{(bf16_t*)S, nullptr, 3 * D, IN(15) + (size_t)j * D, IN(18) + (size_t)j * D, 1.f, 0}};
            run_gemm(lds, HB, WM + 8 * MiB / 2, M, 3 * D, 256, 1 << 30, 0, E);
        }
        else if (HAS(OP_REC) && op == OP_REC) { rwkv_rec_phase(lds, (const bf16_t*)(S + 192 * MiB), (const bf16_t*)S, HB, IN(23) + (size_t)j * D, IN(24) + (size_t)j * D, IN(25) + (size_t)j * D, IN(26) + (size_t)j * D, IN(27) + (size_t)j * D); }
        else if (HAS(OP_PLAIN) && op == OP_PLAIN) {
            const int ng = sub == 0 ? 1 : (sub == 1 ? 2 : 3);
            for (int g = 0; g < ng; ++g) {
                const bf16_t* A; const bf16_t* Bt; int M_, N_, asplit = 1 << 30; size_t astride = 0; EpiP P{nullptr, nullptr, 0, nullptr, nullptr, 1.f, 0};
                if (sub == 0) { A = (const bf16_t*)S; Bt = WM; M_ = M; N_ = 3 * D; asplit = 4; astride = (size_t)M * D * 2; P.O = (bf16_t*)(S + 192 * MiB); P.ldc = 3 * D; }
                else if (sub == 1) {
                    if (g == 0) { A = HB; Bt = WM; M_ = M; N_ = 2 * D; P.O = (bf16_t*)S; P.ldc = 2 * D; P.scale = 0.125f; P.scale_cols = D; }
                    else { A = WM + 4 * MiB / 2; Bt = HB; M_ = D; N_ = M; P.O = (bf16_t*)(S + 128 * MiB); P.ldc = M; }
                } else {
                    if (g == 0) { A = HB; Bt = WC + WC_Q / 2; M_ = M; N_ = D; P.O = (bf16_t*)S; P.ldc = D; P.scale = 0.0625f; P.scale_cols = D; }
                    else if (g == 1) { A = MEMB; Bt = WC + WC_K / 2; M_ = MM; N_ = D; P.O = WM; P.ldc = D; }
                    else { A = WC + WC_V / 2; Bt = MEMB; M_ = D; N_ = MM; P.O = WM + 8 * MiB / 2; P.ldc = MM; }
                }
                EpiT<0> E{P};
                run_gemm(lds, A, Bt, M_, N_, D, asplit, astride, E);
            }
        }
        else if (HAS(OP_CATT) && op == OP_CATT) { chunk_attn_phase2(lds, (const bf16_t*)S, (const bf16_t*)(S + 128 * MiB), (bf16_t*)(S + 192 * MiB), IN(30) + (size_t)j * 16 * 257); }
        else if (HAS(OP_XATT) && op == OP_XATT) { mem_attn_phase2(lds, (const bf16_t*)S, WM, WM + 8 * MiB / 2, (bf16_t*)(S + 64 * MiB)); }
        else if (HAS(OP_MLP1) && op == OP_MLP1) {
            EpiT<5> E{{(bf16_t*)S, nullptr, FF, nullptr, nullptr, 1.f, 0}};
            run_gemm(lds, HB, WC + WC_W1 / 2, M, FF, D, 1 << 30, 0, E);
        }
        }
    }
}

#ifndef FULLMASK
#define FULLMASK 0xFFFFFFFFu
#endif
#ifndef MK_COOP
#define MK_COOP 0
#endif
template <unsigned MASK> static void launch_one(const Args& a, hipStream_t stream) {
    static bool attr = false;
    if (!attr) { attr = true; if (hipFuncSetAttribute((const void*)fwd<MASK>, hipFuncAttributeMaxDynamicSharedMemorySize, LDS_BYTES) != hipSuccess) fprintf(stderr, "kernel_launch: hipFuncSetAttribute failed\n"); }
    hipLaunchKernelGGL(fwd<MASK>, dim3(256), dim3(512), LDS_BYTES, stream, a);
}
extern "C" void kernel_launch(void* const* d_in, const int* in_sizes, int n_in, void* d_out, int out_size, void* d_ws, size_t ws_size, hipStream_t stream) {
    static int ready = 0;
    if (ready == 0) {
        ready = 1;
        if (n_in != 37 || out_size != M * D || ws_size < WS_END) { fprintf(stderr, "kernel_launch: unexpected shapes: n_in %d out %d ws %zu (need %zu)\n", n_in, out_size, ws_size, (size_t)WS_END); ready = -1; }
    }
    if (ready < 0) return;
    Args a{};
    for (int i = 0; i < 37; ++i) a.in[i] = (const float*)d_in[i];
    a.out = (float*)d_out; a.ws = (unsigned char*)d_ws;
#if MK_COOP
    static bool attr = false;
    if (!attr) { attr = true; if (hipFuncSetAttribute((const void*)fwd<FULLMASK>, hipFuncAttributeMaxDynamicSharedMemorySize, LDS_BYTES) != hipSuccess) fprintf(stderr, "kernel_launch: hipFuncSetAttribute failed\n"); }
    a.lo = 0; a.hi = NPHASE;
    if (hipMemsetAsync(d_ws, 0, 16384, stream) != hipSuccess) fprintf(stderr, "kernel_launch: memset of barrier words failed\n");
    void* args[] = {&a};
    hipError_t e = hipLaunchCooperativeKernel((const void*)fwd<FULLMASK>, dim3(256), dim3(512), args, LDS_BYTES, stream);
    if (e != hipSuccess) fprintf(stderr, "kernel_launch: cooperative launch failed: %s\n", hipGetErrorString(e));
#else
    for (int pc = 0; pc < NPHASE; ++pc) {
        a.lo = pc; a.hi = pc + 1;
        int L, s, kind, j, op, sub; decode_phase(pc, L, s, kind, j, op, sub);
        switch (op) {
            case OP_PRO: launch_one<1u << OP_PRO>(a, stream); break;
            case OP_WIN: launch_one<1u << OP_WIN>(a, stream); break;
            case OP_CONV: launch_one<1u << OP_CONV>(a, stream); break;
            case OP_GATES: launch_one<1u << OP_GATES>(a, stream); break;
            case OP_SCAN: launch_one<1u << OP_SCAN>(a, stream); break;
            case OP_RES: launch_one<1u << OP_RES>(a, stream); break;
            case OP_LN: launch_one<1u << OP_LN>(a, stream); break;
            case OP_PREP: launch_one<1u << OP_PREP>(a, stream); break;
            case OP_L1: launch_one<1u << OP_L1>(a, stream); break;
            case OP_PLAIN: launch_one<1u << OP_PLAIN>(a, stream); break;
            case OP_L2: launch_one<1u << OP_L2>(a, stream); break;
            case OP_REC: launch_one<1u << OP_REC>(a, stream); break;
            case OP_CATT: launch_one<1u << OP_CATT>(a, stream); break;
            case OP_XATT: launch_one<1u << OP_XATT>(a, stream); break;
            default: launch_one<1u << OP_MLP1>(a, stream); break;
        }
    }
#endif
}
```
